# Optimizing an MI355X kernel written in HIP

```python
import jax, jax.numpy as jnp
from jax import lax
import numpy as np

D_MODEL = 1024
BATCH = 8
SEQ = 2048
DEPTH = 4

N_MIXERS = 2
EXPAND = 2
D_INNER = EXPAND * D_MODEL
CHUNK = 128
A_GROUPS = 8
CONV_W = 3
EPS = 1e-6
N_A = (DEPTH + 1) // 2
N_B = DEPTH // 2

kernel_name = "hybrid_gmlp_shortconv_trunk"


def rmsnorm(x, g):
    xf = x.astype(jnp.float32)
    y = xf * lax.rsqrt(jnp.mean(xf * xf, axis=-1, keepdims=True) + EPS)
    return (y * g.astype(jnp.float32)).astype(x.dtype)


def mixer_a(h, w_in, v_norm_g, w_s, b_s, w_out):
    b, s, _ = h.shape
    u, v, z = jnp.split(h @ w_in, 3, axis=-1)
    v = rmsnorm(v, v_norm_g)
    vc = v.reshape(b, s // CHUNK, CHUNK, A_GROUPS, D_INNER // A_GROUPS)
    causal = jnp.tril(jnp.ones((CHUNK, CHUNK), dtype=bool))
    ws = jnp.where(causal[None], w_s, jnp.zeros((), w_s.dtype))
    mixed = jnp.einsum("gts,bnsgc->bntgc", ws, vc)
    mixed = mixed + jnp.transpose(b_s)[None, None, :, :, None]
    mixed = mixed.reshape(b, s, D_INNER)
    y = u * mixed * jax.nn.silu(z)
    return y @ w_out


def mixer_b(h, w_in, w_conv, w_out):
    s = h.shape[1]
    bg, cg, xs, z = jnp.split(h @ w_in, 4, axis=-1)
    xc = cg * xs
    xp = jnp.pad(xc, ((0, 0), (CONV_W - 1, 0), (0, 0)))
    conv = w_conv[0] * xp[:, 0:s, :]
    for k in range(1, CONV_W):
        conv = conv + w_conv[k] * xp[:, k:k + s, :]
    y = bg * conv * jax.nn.silu(z)
    return y @ w_out


def setup_inputs(seed: int = 0) -> dict:
    key = jax.random.key(seed)
    ks = jax.random.split(key, 12)
    f32 = jnp.float32
    x = jax.random.normal(ks[0], (BATCH, SEQ, D_MODEL), f32)
    norm_g = 1.0 + 0.02 * jax.random.normal(ks[1], (DEPTH, D_MODEL), f32)
    final_g = 1.0 + 0.02 * jax.random.normal(ks[2], (D_MODEL,), f32)
    a_w_in = jax.random.normal(ks[3], (N_A, D_MODEL, 3 * D_INNER), f32) * D_MODEL ** -0.5
    a_v_norm_g = 1.0 + 0.02 * jax.random.normal(ks[4], (N_A, D_INNER), f32)
    a_w_s = jax.random.normal(ks[5], (N_A, A_GROUPS, CHUNK, CHUNK), f32) * CHUNK ** -0.5
    a_b_s = 1.0 + 0.1 * jax.random.normal(ks[6], (N_A, A_GROUPS, CHUNK), f32)
    a_w_out = jax.random.normal(ks[7], (N_A, D_INNER, D_MODEL), f32) * D_INNER ** -0.5
    b_w_in = jax.random.normal(ks[8], (N_B, D_MODEL, 4 * D_INNER), f32) * D_MODEL ** -0.5
    b_w_conv = jax.random.normal(ks[9], (N_B, CONV_W, D_INNER), f32) * CONV_W ** -0.5
    b_w_out = jax.random.normal(ks[10], (N_B, D_INNER, D_MODEL), f32) * D_INNER ** -0.5
    return {"x": x, "norm_g": norm_g, "final_g": final_g,
            "a_w_in": a_w_in, "a_v_norm_g": a_v_norm_g, "a_w_s": a_w_s, "a_b_s": a_b_s,
            "a_w_out": a_w_out, "b_w_in": b_w_in, "b_w_conv": b_w_conv, "b_w_out": b_w_out}


def reference(x, norm_g, final_g, a_w_in, a_v_norm_g, a_w_s, a_b_s, a_w_out,
              b_w_in, b_w_conv, b_w_out):
    for i in range(DEPTH):
        h = rmsnorm(x, norm_g[i])
        j = i // N_MIXERS
        if i % N_MIXERS == 0:
            x = x + mixer_a(h, a_w_in[j], a_v_norm_g[j], a_w_s[j], a_b_s[j], a_w_out[j])
        else:
            x = x + mixer_b(h, b_w_in[j], b_w_conv[j], b_w_out[j])
    return rmsnorm(x, final_g)
```

```cpp
#include <hip/hip_runtime.h>
#include <hip/hip_cooperative_groups.h>
#include <cstdio>
#include <cstdint>
namespace pg8 {
#define PG8_LAS __attribute__((address_space(3)))
typedef unsigned short bf16_t;
typedef short bf16x8 __attribute__((ext_vector_type(8)));
typedef float f32x4 __attribute__((ext_vector_type(4)));
typedef unsigned u32x4 __attribute__((ext_vector_type(4)));
constexpr int BM = 256, BK = 64, HALF = 128, HTB = HALF * BK * 2  , STAGE_BYTES = 8 * HTB, NXCD = 8, WGM = 8;

__host__ __device__ __forceinline__ int lds_byte(int r, int c) { const int st = (r >> 4) * 2 + (c >> 5), rr = r & 15, cc = c & 31, ob = rr * 64 + cc * 2; return st * 1024 + (ob ^ (((ob >> 9) & 1) << 5)); }
__host__ __device__ __forceinline__ void stage_rc(int b, int& R, int& C) { const int st = b / 1024, sb = b % 1024, swz = sb ^ (((sb >> 9) & 1) << 5); R = (st >> 1) * 16 + swz / 64; C = (st & 1) * 32 + (swz % 64) / 2; }
__host__ __device__ __forceinline__ int perm32(int rho) { const int n = rho >> 4, i = rho & 15; return 8 * (i >> 2) + 4 * n + (i & 3); }

struct Unit { int pm, pn; };
struct Gemm { const bf16_t* A; const bf16_t* Bt; int M, N, K; };

struct StaticOrder {
    int nM, nN, nwg, G, c;
    __host__ __device__ void init(int M, int N, int G_, int c_) { nM = M / BM; nN = N / BM; nwg = nM * nN; G = G_; c = c_; }
    __host__ __device__ bool next(int i, Unit& u) const {
        const long L = (long)i * G + c; if (L >= nwg) return false;
        int wgid = (int)L; { const int q = nwg / NXCD, r = nwg % NXCD, xcd = wgid % NXCD, off = wgid / NXCD; wgid = (xcd < r ? xcd * (q + 1) : r * (q + 1) + (xcd - r) * q) + off; }
        const int nig = WGM * nN, gid = wgid / nig, fm = gid * WGM, gsz = (nM - fm) < WGM ? (nM - fm) : WGM;
        u.pm = fm + ((wgid % nig) % gsz); u.pn = (wgid % nig) / gsz; return true;
    }
    __device__ __forceinline__ void a_ready(const Unit&) const {}
    __device__ __forceinline__ void done(const Unit&) const {}
};
__device__ __forceinline__ unsigned cvt_pk_bf16(float lo, float hi) { unsigned r; asm volatile("v_cvt_pk_bf16_f32 %0, %1, %2" : "=v"(r) : "v"(lo), "v"(hi)); return r; }

typedef unsigned u32x2 __attribute__((ext_vector_type(2)));
constexpr float RMS_EPS = 1e-6f;
__device__ __forceinline__ float silu_f(float z) { return z * __builtin_amdgcn_rcpf(1.0f + __expf(-z)); }
__device__ __forceinline__ float gate_f(float z, float c1, float rs2) { return rs2 * __builtin_amdgcn_rcpf(1.0f + __builtin_amdgcn_exp2f(z * c1)); }
__device__ __forceinline__ f32x4 gate4(f32x4 z, float c1, float rs2) {
    const f32x4 zc = z * c1; f32x4 e;
    e[0] = __builtin_amdgcn_exp2f(zc[0]); e[1] = __builtin_amdgcn_exp2f(zc[1]); e[2] = __builtin_amdgcn_exp2f(zc[2]); e[3] = __builtin_amdgcn_exp2f(zc[3]);
    const f32x4 d = e + 1.0f; f32x4 r;
    r[0] = __builtin_amdgcn_rcpf(d[0]); r[1] = __builtin_amdgcn_rcpf(d[1]); r[2] = __builtin_amdgcn_rcpf(d[2]); r[3] = __builtin_amdgcn_rcpf(d[3]);
    return r * rs2;
}
__device__ __forceinline__ float row_rs16(const float* ssp, int row) {
    const f32x4* sp = (const f32x4*)(ssp + (size_t)row * 16);
    const f32x4 a = sp[0], b = sp[1], c = sp[2], d = sp[3];
    const float s = ((a[0] + a[1]) + (a[2] + a[3])) + ((b[0] + b[1]) + (b[2] + b[3])) + ((c[0] + c[1]) + (c[2] + c[3])) + ((d[0] + d[1]) + (d[2] + d[3]));
    return __builtin_amdgcn_rsqf(s * (1.0f / 1024.0f) + RMS_EPS);
}

struct XorSh { int a16, a32; };
__device__ __forceinline__ XorSh xorsh_make() { const int l = (int)__builtin_amdgcn_mbcnt_hi(~0u, __builtin_amdgcn_mbcnt_lo(~0u, 0u)); XorSh x; x.a16 = (l ^ 16) << 2; x.a32 = (l ^ 32) << 2; return x; }
__device__ __forceinline__ float xorsh_sum4(const XorSh& x, float v) {
    v += __builtin_bit_cast(float, __builtin_amdgcn_ds_bpermute(x.a16, __builtin_bit_cast(int, v)));
    v += __builtin_bit_cast(float, __builtin_amdgcn_ds_bpermute(x.a32, __builtin_bit_cast(int, v)));
    return v;
}
__device__ __forceinline__ void load_rs8(const float* ssp, int row0, int fq, float (&rs)[2][4]) {
    f32x4 t[2][4];
#pragma unroll
    for (int ai = 0; ai < 2; ++ai)
#pragma unroll
        for (int m = 0; m < 4; ++m) t[ai][m] = *(const f32x4*)(ssp + (size_t)(row0 + ai * HALF + m * 16) * 16 + 4 * fq);
#pragma unroll
    for (int ai = 0; ai < 2; ++ai)
#pragma unroll
        for (int m = 0; m < 4; ++m) { float s = (t[ai][m][0] + t[ai][m][1]) + (t[ai][m][2] + t[ai][m][3]); s += __shfl_xor(s, 16); s += __shfl_xor(s, 32);
            rs[ai][m] = __builtin_amdgcn_rsqf(s * (1.0f / 1024.0f) + RMS_EPS); }
}

__device__ __forceinline__ void rs_to_lds(const float* ssp, PG8_LAS float* RS, const Unit& u, int wr, int wc, int fr, int fq) {
    float rs[2][4]; load_rs8(ssp, u.pm * BM + wr * 64 + fr, fq, rs);
    if (wc == 0 && fq == 0) {
#pragma unroll
        for (int ai = 0; ai < 2; ++ai)
#pragma unroll
            for (int m = 0; m < 4; ++m) RS[ai * HALF + wr * 64 + m * 16 + fr] = rs[ai][m]; }
}
__device__ __forceinline__ void rs_from_lds(const float* ssp, const PG8_LAS float* RS, bool cached, const Unit& u, int wr, int fr, int fq, float (&rs)[2][4]) {
    if (cached) {
#pragma unroll
        for (int ai = 0; ai < 2; ++ai)
#pragma unroll
            for (int m = 0; m < 4; ++m) rs[ai][m] = RS[ai * HALF + wr * 64 + m * 16 + fr];
    } else load_rs8(ssp, u.pm * BM + wr * 64 + fr, fq, rs);
}

struct EpiA1 {
    static constexpr bool PERM = false, AFTER_DRAIN = false, PREFETCH = false, INIT_ACC = false;
    const float* ssp; bf16_t* UZ; bf16_t* V; float* ssvp; const float* gv; PG8_LAS float* RS;
    struct Pre { int pm; };
    __device__ __forceinline__ void prep(Pre& p, const Unit& u, int wr, int wc, int fr, int fq) const { p.pm = u.pm; rs_to_lds(ssp, RS, u, wr, wc, fr, fq); }
    __device__ __forceinline__ void operator()(const f32x4 (&acc)[2][2][4][2], const Unit& u, Pre& pre, int wr, int wc, int fr, int fq) const {
        const int row0 = u.pm * BM + wr * 64 + fr;
        float rsa[2][4]; rs_from_lds(ssp, RS, u.pm == pre.pm, u, wr, fr, fq, rsa);
        if (u.pn < 16) {
            const int col0 = 128 * u.pn + 32 * wc + 8 * fq;
#pragma unroll
            for (int ai = 0; ai < 2; ++ai)
#pragma unroll
                for (int m = 0; m < 4; ++m) { const int row = row0 + ai * HALF + m * 16; const float rs = rsa[ai][m], rs2 = rs * rs, c1 = rs * -1.4426950408889634f;
                    const f32x4 o0 = (acc[ai][0][m][0] * acc[ai][1][m][0]) * gate4(acc[ai][1][m][0], c1, rs2), o1 = (acc[ai][0][m][1] * acc[ai][1][m][1]) * gate4(acc[ai][1][m][1], c1, rs2);
                    u32x4 w; w.x = cvt_pk_bf16(o0[0], o0[1]); w.y = cvt_pk_bf16(o0[2], o0[3]); w.z = cvt_pk_bf16(o1[0], o1[1]); w.w = cvt_pk_bf16(o1[2], o1[3]);
                    *(u32x4*)(UZ + (size_t)row * 2048 + col0) = w; }
        } else {
            const int g = u.pn - 16, col0 = 256 * g + 32 * wc + 8 * fq; const XorSh xs = xorsh_make();
            f32x4 gvv[2][2];
#pragma unroll
            for (int bj = 0; bj < 2; ++bj)
#pragma unroll
                for (int n = 0; n < 2; ++n) gvv[bj][n] = *(const f32x4*)(gv + col0 + 128 * bj + 4 * n);
#pragma unroll
            for (int ai = 0; ai < 2; ++ai)
#pragma unroll
                for (int m = 0; m < 4; ++m) { const int row = row0 + ai * HALF + m * 16; const float rs = rsa[ai][m];
                    f32x4 sq = (f32x4){0.f, 0.f, 0.f, 0.f};
#pragma unroll
                    for (int bj = 0; bj < 2; ++bj) { f32x4 v0 = acc[ai][bj][m][0] * rs, v1 = acc[ai][bj][m][1] * rs;
                        sq = sq + v0 * v0; sq = sq + v1 * v1;
                        v0 = v0 * gvv[bj][0]; v1 = v1 * gvv[bj][1];
                        u32x4 w; w.x = cvt_pk_bf16(v0[0], v0[1]); w.y = cvt_pk_bf16(v0[2], v0[3]); w.z = cvt_pk_bf16(v1[0], v1[1]); w.w = cvt_pk_bf16(v1[2], v1[3]);
                        *(u32x4*)(V + (size_t)row * 2048 + col0 + 128 * bj) = w; }
                    const float ss = xorsh_sum4(xs, (sq[0] + sq[1]) + (sq[2] + sq[3]));
                    if (fq == 0) ssvp[(size_t)row * 32 + g * 4 + wc] = ss; }
        }
    }
};

__device__ __forceinline__ float dpp_f(float old, float src, const int ctrl_sel) {
    const int o = __builtin_bit_cast(int, old), v = __builtin_bit_cast(int, src); int r;
    if (ctrl_sel == 0) r = __builtin_amdgcn_update_dpp(o, v, 0x111, 0xf, 0xf, false);
    else if (ctrl_sel == 1) r = __builtin_amdgcn_update_dpp(o, v, 0x112, 0xf, 0xf, false);
    else if (ctrl_sel == 2) r = __builtin_amdgcn_update_dpp(o, v, 0x121, 0xf, 0xf, false);
    else r = __builtin_amdgcn_update_dpp(o, v, 0x122, 0xf, 0xf, false);
    return __builtin_bit_cast(float, r);
}
__device__ __forceinline__ float dpp_ror(float src, const int n) {
    const int v = __builtin_bit_cast(int, src);
    const int r = (n == 1) ? __builtin_amdgcn_mov_dpp(v, 0x121, 0xf, 0xf, false) : __builtin_amdgcn_mov_dpp(v, 0x122, 0xf, 0xf, false);
    return __builtin_bit_cast(float, r);
}
struct EpiB1 {
    static constexpr bool PERM = false, AFTER_DRAIN = false, PREFETCH = false, INIT_ACC = false;
    const float* ssp; bf16_t* Y; const float* wconv; float* PL; float* P0; float* Q0; PG8_LAS float* X; PG8_LAS float* RS; int dry;
    struct Pre { int pm; };
    __device__ __forceinline__ void prep(Pre& p, const Unit& u, int wr, int wc, int fr, int fq) const { p.pm = u.pm; rs_to_lds(ssp, RS, u, wr, wc, fr, fq); }
    __device__ __forceinline__ void operator()(const f32x4 (&acc)[2][2][4][2], const Unit& u, Pre& pre, int wr, int wc, int fr, int fq) const {
        if (dry == 2) return;
        const int row0 = u.pm * BM + wr * 64 + fr, c4 = 64 * u.pn + 16 * wc + 4 * fq;
        float rsa[2][4]; rs_from_lds(ssp, RS, u.pm == pre.pm, u, wr, fr, fq, rsa);
        const bool seq_start = (u.pm & 7) == 0;
        const f32x4 w0 = *(const f32x4*)(wconv + c4), w1 = *(const f32x4*)(wconv + 2048 + c4), w2 = *(const f32x4*)(wconv + 4096 + c4);
#pragma unroll
        for (int ai = 0; ai < 2; ++ai) { const float rs = rsa[ai][3]; const f32x4 p3 = acc[ai][1][3][0] * acc[ai][1][3][1] * (rs * rs);
            if (fr >= 14) { *(PG8_LAS f32x4*)(X + (((((ai * 2 + wr) * 4 + wc) * 2 + (fr - 14)) * 4 + fq) * 4)) = p3;
                if (ai == 1 && wr == 1 && !dry) *(f32x4*)(PL + ((size_t)u.pm * 2 + (fr - 14)) * 2048 + c4) = p3; } }
        asm volatile("s_waitcnt lgkmcnt(0)" ::: "memory"); __builtin_amdgcn_s_barrier(); asm volatile("" ::: "memory");
#pragma unroll
        for (int ai = 0; ai < 2; ++ai) {
            f32x4 carry = (f32x4){0.f, 0.f, 0.f, 0.f};
            if (ai == 1 || wr == 1) { const int sai = wr ? ai : ai - 1, swr = wr ? 0 : 1; carry = *(const PG8_LAS f32x4*)(X + (((((sai * 2 + swr) * 4 + wc) * 2 + (fr & 1)) * 4 + fq) * 4)); }
#pragma unroll
            for (int m = 0; m < 4; ++m) { const int row = row0 + ai * HALF + m * 16; const float rs = rsa[ai][m], rs2 = rs * rs, c1 = rs * -1.4426950408889634f;
                const f32x4 p = acc[ai][1][m][0] * acc[ai][1][m][1] * rs2;
                const f32x4 q = (acc[ai][0][m][0] * acc[ai][0][m][1]) * gate4(acc[ai][0][m][1], c1, rs2);
                f32x4 pv1, pv2;
#pragma unroll
                for (int j = 0; j < 4; ++j) { pv1[j] = dpp_f(dpp_ror(carry[j], 1), p[j], 0); pv2[j] = dpp_f(dpp_ror(carry[j], 2), p[j], 1); }
                const f32x4 y = q * (w0 * pv2 + (w1 * pv1 + w2 * p));
                carry = p;
                const bool raw = (ai == 0) && (m == 0) && (wr == 0) && !seq_start && (fr < 2);
                u32x2 w; w.x = cvt_pk_bf16(y[0], y[1]); w.y = cvt_pk_bf16(y[2], y[3]);
                asm volatile("" :: "v"(w.x), "v"(w.y));
                if (!dry) { if (raw) { *(f32x4*)(P0 + ((size_t)u.pm * 2 + fr) * 2048 + c4) = p; *(f32x4*)(Q0 + ((size_t)u.pm * 2 + fr) * 2048 + c4) = q; }
                            else *(u32x2*)(Y + (size_t)row * 2048 + c4) = w; } }
        }
    }
};

__device__ __forceinline__ float bf_lo(unsigned w) { return __builtin_bit_cast(float, w << 16); }
__device__ __forceinline__ float bf_hi(unsigned w) { return __builtin_bit_cast(float, w & 0xffff0000u); }
struct EpiOut {
    static constexpr bool PERM = false, AFTER_DRAIN = false;
    bf16_t* XB; float* ssp; int dry;
    static constexpr bool PREFETCH = false, INIT_ACC = true;
    struct Pre {};
    __device__ __forceinline__ void prep(Pre&, const Unit&, int, int, int, int) const {}
    __device__ __forceinline__ void prefetch(const Unit& u, PG8_LAS unsigned char* pf, int tid, int wid) const {
#pragma unroll
        for (int i = 0; i < 2; ++i) { const int L = tid + 512 * i, row = L >> 2, seg = L & 3;
            __builtin_amdgcn_global_load_lds((const unsigned*)(XB + (size_t)(u.pm * BM + row) * 1024 + u.pn * BM + seg * 64), (PG8_LAS unsigned*)(pf + wid * 256 + i * 2048), 4, 0, 0); }
    }
    __device__ __forceinline__ void init_acc(f32x4 (&acc)[2][2][4][2], const Unit& u, int wr, int wc, int fr, int fq) const {
        const int row0 = u.pm * BM + wr * 64 + fr, col0 = u.pn * BM + wc * 32 + 8 * fq;
#pragma unroll
        for (int ai = 0; ai < 2; ++ai) {
            u32x4 xo[4][2];
#pragma unroll
            for (int m = 0; m < 4; ++m)
#pragma unroll
                for (int bj = 0; bj < 2; ++bj) xo[m][bj] = *(const u32x4*)(XB + (size_t)(row0 + ai * HALF + m * 16) * 1024 + col0 + bj * HALF);
#pragma unroll
            for (int m = 0; m < 4; ++m)
#pragma unroll
                for (int bj = 0; bj < 2; ++bj) { const u32x4 xw = xo[m][bj];
                    acc[ai][bj][m][0] = (f32x4){bf_lo(xw.x), bf_hi(xw.x), bf_lo(xw.y), bf_hi(xw.y)}; acc[ai][bj][m][1] = (f32x4){bf_lo(xw.z), bf_hi(xw.z), bf_lo(xw.w), bf_hi(xw.w)}; }
        }
    }
    __device__ __forceinline__ void operator()(const f32x4 (&acc)[2][2][4][2], const Unit& u, Pre&, int wr, int wc, int fr, int fq) const {
        if (dry == 2) return;
        const int row0 = u.pm * BM + wr * 64 + fr, col0 = u.pn * BM + wc * 32 + 8 * fq; const XorSh xs = xorsh_make();
#pragma unroll
        for (int ai = 0; ai < 2; ++ai)
#pragma unroll
            for (int m = 0; m < 4; ++m) { const int row = row0 + ai * HALF + m * 16; const size_t off = (size_t)row * 1024 + col0; f32x4 sq = (f32x4){0.f, 0.f, 0.f, 0.f};
#pragma unroll
                for (int bj = 0; bj < 2; ++bj) { const f32x4 o0 = acc[ai][bj][m][0], o1 = acc[ai][bj][m][1];
                    sq = sq + o0 * o0; sq = sq + o1 * o1;
                    u32x4 w; w.x = cvt_pk_bf16(o0[0], o0[1]); w.y = cvt_pk_bf16(o0[2], o0[3]); w.z = cvt_pk_bf16(o1[0], o1[1]); w.w = cvt_pk_bf16(o1[2], o1[3]);
                    asm volatile("" :: "v"(w.x), "v"(w.y), "v"(w.z), "v"(w.w));
                    if (!dry) *(u32x4*)(XB + off + bj * HALF) = w; }
                const float ss = xorsh_sum4(xs, (sq[0] + sq[1]) + (sq[2] + sq[3]));
                if (fq == 0 && !dry) ssp[(size_t)row * 16 + u.pn * 4 + wc] = ss; }
    }
};

template <class Epi, class Sched, bool ALIGN_EPI = false, bool SP2 = false>
__device__ __forceinline__ void gemm_phase(PG8_LAS unsigned char* lds, const Gemm g, const Sched& S, const Epi& E) {
    int tid_l = threadIdx.x; asm volatile("" : "+v"(tid_l));
    const int tid = tid_l, wid = __builtin_amdgcn_readfirstlane(tid >> 6), lane = tid & 63, wr = wid >> 2, wc = wid & 3, fr = lane & 15, fq = lane >> 4;
    const int K = g.K, nt = K / BK;
    unsigned voffA[2], voffB[2];
#pragma unroll
    for (int i = 0; i < 2; ++i) { int R, C; stage_rc(tid * 16 + i * 8192, R, C); const int Rb = Epi::PERM ? ((R & ~31) + perm32(R & 31)) : R;
        voffA[i] = (unsigned)(R * K + C) * 2u; voffB[i] = (unsigned)(Rb * K + C) * 2u; }
    const size_t kstep = (size_t)(BK * 2);
    const size_t hstep = (size_t)HALF * K * 2;
    const size_t tstep = 2 * hstep;
    const unsigned ldsw = (unsigned)wid * 1024u;
    const int aoff = lds_byte(wr * 64 + fr, fq * 8), boff = lds_byte(wc * 32 + fr, fq * 8);
#define PG8_SA(b, h) (((b) * 2 + (h)) * HTB)
#define PG8_SB(b, h) ((4 + (b) * 2 + (h)) * HTB)
#define PG8_STAGE(bufoff, gbase, voff) do { _Pragma("unroll") for (int _i = 0; _i < 2; ++_i) \
        __builtin_amdgcn_global_load_lds((const unsigned*)((const char*)(gbase) + (voff)[_i]), (PG8_LAS unsigned*)(lds + (bufoff) + ldsw + _i * 8192), 16, 0, 0); } while (0)
#define PG8_LDA(dst, b, h) do { _Pragma("unroll") for (int m = 0; m < 4; ++m) _Pragma("unroll") for (int k = 0; k < 2; ++k) dst[m][k] = *(const PG8_LAS bf16x8*)(lds + PG8_SA(b, h) + aoff + m * 2048 + k * 1024); } while (0)
#define PG8_LDB(dst, b, h) do { _Pragma("unroll") for (int n = 0; n < 2; ++n) _Pragma("unroll") for (int k = 0; k < 2; ++k) dst[n][k] = *(const PG8_LAS bf16x8*)(lds + PG8_SB(b, h) + boff + n * 2048 + k * 1024); } while (0)
#define PG8_MMA(ai, bj, At, Bt) do { __builtin_amdgcn_s_setprio(1); _Pragma("unroll") for (int m = 0; m < 4; ++m) _Pragma("unroll") for (int n = 0; n < 2; ++n) _Pragma("unroll") for (int k = 0; k < 2; ++k) \
        acc[ai][bj][m][n] = __builtin_amdgcn_mfma_f32_16x16x32_bf16(Bt[n][k], At[m][k], acc[ai][bj][m][n], 0, 0, 0); __builtin_amdgcn_s_setprio(0); } while (0)
#define PG8_WAIT_V(n) asm volatile("s_waitcnt vmcnt(" #n ")" ::: "memory")
#define PG8_WAIT_L(n) asm volatile("s_waitcnt lgkmcnt(" #n ")" ::: "memory")
#define PG8_BAR __builtin_amdgcn_s_barrier()
#define PG8_SCHED __builtin_amdgcn_sched_barrier(0)
    Unit cur, nxt; int ui = 0;
    if (!S.next(0, cur)) return;
    f32x4 acc[2][2][4][2];
    if constexpr (Epi::INIT_ACC) E.init_acc(acc, cur, wr, wc, fr, fq);
    else {
#pragma unroll
    for (int a = 0; a < 2; ++a)
#pragma unroll
        for (int b = 0; b < 2; ++b)
#pragma unroll
            for (int m = 0; m < 4; ++m)
#pragma unroll
                for (int n = 0; n < 2; ++n) acc[a][b][m][n] = (f32x4){0.f, 0.f, 0.f, 0.f};
    }
    bf16x8 At[4][2], B0[2][2], B1[2][2];
    const char* cA = (const char*)g.A + (size_t)cur.pm * tstep; const char* cB = (const char*)g.Bt + (size_t)cur.pn * tstep;
    S.a_ready(cur);
    typename Epi::Pre pre; E.prep(pre, cur, wr, wc, fr, fq);
    if constexpr (SP2) {
        PG8_STAGE(PG8_SB(0, 0), cB, voffB); PG8_STAGE(PG8_SB(0, 1), cB + hstep, voffB); PG8_STAGE(PG8_SA(0, 0), cA, voffA); PG8_STAGE(PG8_SA(0, 1), cA + hstep, voffA);
        if (wr == 1) PG8_BAR;
        PG8_WAIT_V(2); PG8_BAR;
        PG8_STAGE(PG8_SB(1, 0), cB + kstep, voffB); PG8_STAGE(PG8_SA(1, 0), cA + kstep, voffA); PG8_STAGE(PG8_SB(1, 1), cB + hstep + kstep, voffB);
        PG8_WAIT_V(6); PG8_BAR;
    } else {
        PG8_STAGE(PG8_SB(0, 0), cB, voffB); PG8_STAGE(PG8_SA(0, 0), cA, voffA); PG8_STAGE(PG8_SB(0, 1), cB + hstep, voffB); PG8_STAGE(PG8_SA(0, 1), cA + hstep, voffA);
        if (wr == 1) PG8_BAR;
        PG8_WAIT_V(4); PG8_BAR;
        PG8_STAGE(PG8_SB(1, 0), cB + kstep, voffB); PG8_STAGE(PG8_SA(1, 0), cA + kstep, voffA); PG8_STAGE(PG8_SB(1, 1), cB + hstep + kstep, voffB);
        PG8_WAIT_V(6); PG8_BAR;
    }
    for (;;) {
        const bool has_next = S.next(ui + 1, nxt);
        const char* nA = has_next ? (const char*)g.A + (size_t)nxt.pm * tstep : cA; const char* nB = has_next ? (const char*)g.Bt + (size_t)nxt.pn * tstep : cB;
        for (int t = 0; t < nt; t += 2) {
            const bool last = (t == nt - 2);
            const char* a1 = cA + (size_t)(t + 1) * kstep;
            const char* a2 = last ? nA : cA + (size_t)(t + 2) * kstep; const char* b2 = last ? nB : cB + (size_t)(t + 2) * kstep;
            const char* a3 = a2 + kstep; const char* b3 = b2 + kstep;
            if (last && has_next) S.a_ready(nxt);
            if constexpr (Epi::PREFETCH) { if (last) E.prefetch(cur, lds + 131072 + 4096, tid, wid); }
            if constexpr (SP2) {
            PG8_LDB(B0, 0, 0); PG8_LDB(B1, 0, 1); PG8_SCHED; PG8_LDA(At, 0, 0); PG8_STAGE(PG8_SA(1, 1), a1 + hstep, voffA);
            PG8_WAIT_V(8); PG8_WAIT_L(0); PG8_BAR; PG8_MMA(0, 0, At, B0); PG8_MMA(0, 1, At, B1); PG8_BAR; PG8_SCHED;
            PG8_LDA(At, 0, 1); PG8_STAGE(PG8_SB(0, 0), b2, voffB); PG8_STAGE(PG8_SB(0, 1), b2 + hstep, voffB); PG8_STAGE(PG8_SA(0, 0), a2, voffA);
            PG8_WAIT_V(8); PG8_WAIT_L(0); PG8_BAR; PG8_MMA(1, 0, At, B0); PG8_MMA(1, 1, At, B1); PG8_BAR; PG8_SCHED;
            PG8_LDB(B0, 1, 0); PG8_LDB(B1, 1, 1); PG8_SCHED; PG8_LDA(At, 1, 0); PG8_STAGE(PG8_SA(0, 1), a2 + hstep, voffA);
            PG8_WAIT_V(8); PG8_WAIT_L(0); PG8_BAR; PG8_MMA(0, 0, At, B0); PG8_MMA(0, 1, At, B1); PG8_BAR; PG8_SCHED;
            PG8_LDA(At, 1, 1); PG8_STAGE(PG8_SB(1, 0), b3, voffB); PG8_STAGE(PG8_SB(1, 1), b3 + hstep, voffB); PG8_STAGE(PG8_SA(1, 0), a3, voffA);
            PG8_WAIT_V(8); PG8_WAIT_L(0); PG8_BAR; PG8_MMA(1, 0, At, B0); PG8_MMA(1, 1, At, B1); PG8_BAR; PG8_SCHED;
            } else {
            PG8_LDB(B0, 0, 0); PG8_SCHED; PG8_LDA(At, 0, 0); PG8_STAGE(PG8_SA(1, 1), a1 + hstep, voffA);
            PG8_WAIT_L(8); PG8_BAR; PG8_WAIT_L(0); PG8_MMA(0, 0, At, B0); PG8_BAR; PG8_SCHED;
            PG8_LDB(B1, 0, 1); PG8_STAGE(PG8_SB(0, 0), b2, voffB);
            PG8_BAR; PG8_WAIT_L(0); PG8_MMA(0, 1, At, B1); PG8_BAR;
            PG8_LDA(At, 0, 1); PG8_STAGE(PG8_SA(0, 0), a2, voffA);
            PG8_BAR; PG8_WAIT_L(0); PG8_MMA(1, 0, At, B0); PG8_BAR; PG8_SCHED;
            PG8_STAGE(PG8_SB(0, 1), b2 + hstep, voffB);
            PG8_WAIT_V(6); PG8_BAR; PG8_MMA(1, 1, At, B1); PG8_BAR;
            PG8_LDB(B0, 1, 0); PG8_SCHED; PG8_LDA(At, 1, 0); PG8_STAGE(PG8_SA(0, 1), a2 + hstep, voffA);
            PG8_WAIT_L(8); PG8_BAR; PG8_WAIT_L(0); PG8_MMA(0, 0, At, B0); PG8_BAR; PG8_SCHED;
            PG8_LDB(B1, 1, 1); PG8_STAGE(PG8_SB(1, 0), b3, voffB);
            PG8_BAR; PG8_WAIT_L(0); PG8_MMA(0, 1, At, B1); PG8_BAR;
            PG8_LDA(At, 1, 1); PG8_STAGE(PG8_SA(1, 0), a3, voffA);
            PG8_BAR; PG8_WAIT_L(0); PG8_MMA(1, 0, At, B0); PG8_BAR; PG8_SCHED;
            PG8_STAGE(PG8_SB(1, 1), b3 + hstep, voffB);
            PG8_WAIT_V(6); PG8_BAR; PG8_MMA(1, 1, At, B1); PG8_BAR;
            }
        }
        if constexpr (ALIGN_EPI) { if (wr == 0) PG8_BAR; }
        if constexpr (!Epi::AFTER_DRAIN) { E(acc, cur, pre, wr, wc, fr, fq); S.done(cur); }
        if (!has_next) break;
        if constexpr (Epi::INIT_ACC) E.init_acc(acc, nxt, wr, wc, fr, fq);
        else {
#pragma unroll
        for (int a = 0; a < 2; ++a)
#pragma unroll
            for (int b = 0; b < 2; ++b)
#pragma unroll
                for (int m = 0; m < 4; ++m)
#pragma unroll
                    for (int n = 0; n < 2; ++n) acc[a][b][m][n] = (f32x4){0.f, 0.f, 0.f, 0.f};
        }
        cur = nxt; cA = nA; cB = nB; ++ui;
        if constexpr (ALIGN_EPI) { if (wr == 1) PG8_BAR; }
    }
    PG8_WAIT_V(0);
    if constexpr (!ALIGN_EPI) { if (wr == 0) PG8_BAR; }
    PG8_BAR;
    if constexpr (Epi::AFTER_DRAIN) { E.fused(acc, cur, wr, wc, fr, fq, lds, wid, lane); S.done(cur); }
#undef PG8_SA
#undef PG8_SB
#undef PG8_STAGE
#undef PG8_LDA
#undef PG8_LDB
#undef PG8_MMA
#undef PG8_WAIT_V
#undef PG8_WAIT_L
#undef PG8_BAR
#undef PG8_SCHED
}
}

namespace cg = cooperative_groups;
constexpr int NWAVES = 8;
constexpr int D_MODEL = 1024, BATCH = 8, SEQ = 2048, DEPTH = 4, D_INNER = 2048, CHUNK = 128, A_GROUPS = 8;
constexpr int M_TOK = BATCH * SEQ;
constexpr int NA_IN = 3 * D_INNER, NB_IN = 4 * D_INNER;
constexpr int N_PHASES = 14;
#ifndef MK_ONE_LAUNCH
#define MK_ONE_LAUNCH 1
#endif
#ifndef PROBE_DRYMODE
#define PROBE_DRYMODE 0
#endif
#ifndef PROBE_PHASE
#define PROBE_PHASE (-1)
#endif
constexpr size_t MiB = 1u << 20;
constexpr size_t WS_CTL = 0, CTL_ZERO_BYTES = 64 * 1024;
constexpr size_t WS_WA_IN = 1 * MiB, WS_WB_IN = 25 * MiB, WS_WA_OUT = 57 * MiB, WS_WB_OUT = 65 * MiB;
constexpr size_t WS_XB = 73 * MiB;
constexpr size_t WS_SSP = 105 * MiB;
constexpr size_t WS_SSVP = 106 * MiB;
constexpr size_t WS_UZ = 108 * MiB;
constexpr size_t WS_V = 172 * MiB;
constexpr size_t WS_PL = 236 * MiB, WS_P0 = 237 * MiB, WS_Q0 = 238 * MiB;
constexpr size_t WS_END = 239 * MiB;
constexpr int RS_OFF = 131072 + 3072;
constexpr int EXCH_OFF = 131072 + 1024;
constexpr int MISC_OFF = 131072 + 320;
constexpr int CW_BAR = 4096;
constexpr int LDS_BYTES = 147456;

#define GAS __attribute__((address_space(1)))
#define LAS __attribute__((address_space(3)))
typedef unsigned short bf16;
typedef unsigned v4u __attribute__((ext_vector_type(4)));
typedef unsigned v2u __attribute__((ext_vector_type(2)));
typedef float f32x4 __attribute__((ext_vector_type(4)));
typedef short bf16x8 __attribute__((ext_vector_type(8)));
#define LDS_WAIT() asm volatile("s_waitcnt lgkmcnt(0)" ::: "memory")
__device__ __forceinline__ unsigned f2bf(float f) { unsigned u = __builtin_bit_cast(unsigned, f); return (u + 0x7fffu + ((u >> 16) & 1u)) >> 16; }
__device__ __forceinline__ unsigned pk2(float lo, float hi) { unsigned r; asm("v_cvt_pk_bf16_f32 %0, %1, %2" : "=v"(r) : "v"(lo), "v"(hi)); return r; }
__device__ __forceinline__ float bflo(unsigned w) { return __builtin_bit_cast(float, w << 16); }
__device__ __forceinline__ float bfhi(unsigned w) { return __builtin_bit_cast(float, w & 0xffff0000u); }
__device__ __forceinline__ float wave_sum(float v) {
#pragma unroll
    for (int o = 1; o < 64; o <<= 1) v += __shfl_xor(v, o);
    return v;
}

#define RLX_AGENT __ATOMIC_RELAXED, __HIP_MEMORY_SCOPE_AGENT
#define XB_TMO      128
#define XB_XCNT(j)  (256  + 64 * (j))
#define XB_XSUB(j)  (1280 + 64 * (j))
#define XB_XGEN(j)  (2304 + 64 * (j))
#define XB_TOP      3328
#define XB_TOPGEN   3392
#define XCD_BAR_WORDS 3456
#define XB_SPIN_CAP (1u << 18)

__device__ __forceinline__ unsigned xb_ld(unsigned* p)              { return __hip_atomic_load(p, __ATOMIC_RELAXED, __HIP_MEMORY_SCOPE_AGENT); }
__device__ __forceinline__ unsigned xb_add(unsigned* p, unsigned v) { return __hip_atomic_fetch_add(p, v, __ATOMIC_RELAXED, __HIP_MEMORY_SCOPE_AGENT); }
__device__ __forceinline__ unsigned xb_xcc_id() { return (unsigned)__builtin_amdgcn_s_getreg((3 << 11) | 20) & 0xFu; }
#define XB_SPIN(cond, bar) do { unsigned _sp = 0; while (cond) { __builtin_amdgcn_s_sleep(1); \
    if ((++_sp & 255u) == 0u) { if (xb_ld(&(bar)[XB_TMO])) break; if (_sp > XB_SPIN_CAP) { atomicAdd(&(bar)[XB_TMO], 1u); break; } } } } while (0)

struct XcdBarrier {
    unsigned* bar; unsigned x;
    volatile LAS unsigned* st;
};

__device__ __forceinline__ XcdBarrier xcd_barrier_post(unsigned* bar, volatile LAS unsigned* st) {
    XcdBarrier b; b.bar = bar; b.x = xb_xcc_id(); b.st = st;
    if (threadIdx.x == 0) (void)xb_add(&bar[XB_XCNT(b.x)], 1u);
    return b;
}
__device__ __forceinline__ void xcd_barrier_complete(unsigned* bar, unsigned x, unsigned& nloc, unsigned& nx) {
    const unsigned G = gridDim.x * gridDim.y * gridDim.z;
    unsigned sum, cnt, mine, sp = 0u;
    for (;;) {
        sum = 0u; cnt = 0u; mine = 0u;
#pragma unroll
        for (unsigned j = 0; j < 16; ++j) { const unsigned c = xb_ld(&bar[XB_XCNT(j)]); sum += c; cnt += (c > 0u) ? 1u : 0u; mine = (j == x) ? c : mine; }
        if (sum == G) break;
        __builtin_amdgcn_s_sleep(1);
        if ((++sp & 255u) == 0u) { if (xb_ld(&bar[XB_TMO])) break; if (sp > XB_SPIN_CAP) { atomicAdd(&bar[XB_TMO], 1u); break; } }
    }
    nloc = mine > 0u ? mine : 1u; nx = cnt > 0u ? cnt : 1u;
}

__device__ __forceinline__ void xcd_barrier(const XcdBarrier& b) {
    asm volatile("s_waitcnt vmcnt(0)" ::: "memory");
    __syncthreads();
    if (threadIdx.x == 0) {
        unsigned* bar = b.bar;
        __builtin_amdgcn_s_waitcnt(0);
        unsigned nloc = b.st[0], nx = b.st[1];
        if (nloc == 0u) { xcd_barrier_complete(bar, b.x, nloc, nx); b.st[0] = nloc; b.st[1] = nx; }
        const unsigned old = xb_add(&bar[XB_XSUB(b.x)], 1u);
        const unsigned gen = old / nloc;
        if (old + 1u == (gen + 1u) * nloc) {
            __builtin_amdgcn_fence(__ATOMIC_RELEASE, "agent");
            asm volatile("s_waitcnt vmcnt(0)" ::: "memory");
            const unsigned og = xb_add(&bar[XB_TOP], 1u);
            const unsigned tg = og / nx;
            if (og + 1u == (tg + 1u) * nx) xb_add(&bar[XB_TOPGEN], 1u);
            else XB_SPIN(xb_ld(&bar[XB_TOPGEN]) == tg, bar);
            __builtin_amdgcn_fence(__ATOMIC_ACQUIRE, "agent");
            xb_add(&bar[XB_XGEN(b.x)], 1u);
            asm volatile("s_waitcnt vmcnt(0)" ::: "memory");
        } else {
            XB_SPIN(xb_ld(&bar[XB_XGEN(b.x)]) == gen, bar);
            __builtin_amdgcn_fence(__ATOMIC_ACQUIRE, "agent");
            asm volatile("s_waitcnt vmcnt(0)" ::: "memory");
        }
    }
    __syncthreads();
}

__device__ __forceinline__ int src_col(int mode, int rho) {
    const int pn = rho >> 8, r = rho & 255, bj = r >> 7, wc = (r >> 5) & 3;
    if (mode == 0) { const int p = pg8::perm32(r & 31);
        if (pn < 16) return (bj ? 2 * D_INNER : 0) + 128 * pn + 32 * wc + p;
        return D_INNER + 256 * (pn - 16) + 128 * bj + 32 * wc + p; }
    if (mode == 1) { const int n = (r >> 4) & 1, r16 = r & 15; const int part = bj ? (n ? 2 : 1) : (n ? 3 : 0); return part * D_INNER + 64 * pn + 16 * wc + r16; }
    return (rho & ~31) + pg8::perm32(rho & 31);
}
__device__ __forceinline__ void p0_transpose_item(const float* W, const float* gain, int K, int N, bf16* WT, int mode, LAS float* scr, int item, int lane) {
    const int nblk = N / 32, kb = item / nblk, nb = item % nblk, k0 = 64 * kb, n0 = 32 * nb;
    const int sc = src_col(mode, n0 + (lane & 31));
#pragma unroll 8
    for (int i = 0; i < 32; ++i) { const int kk = 2 * i + (lane >> 5); scr[kk * 33 + (lane & 31)] = __builtin_nontemporal_load(W + (size_t)(k0 + kk) * N + sc); }
    const int c = lane & 7;
    f32x4 g0 = (f32x4){1.f, 1.f, 1.f, 1.f}, g1 = g0;
    if (gain) { g0 = *(const f32x4*)(gain + k0 + 8 * c); g1 = *(const f32x4*)(gain + k0 + 8 * c + 4); }
    LDS_WAIT(); asm volatile("" ::: "memory");
#pragma unroll
    for (int j = 0; j < 4; ++j) { const int n = (lane >> 3) + 8 * j; const LAS float* s = scr + (8 * c) * 33 + n;
        v4u o; o.x = pk2(s[0 * 33] * g0[0], s[1 * 33] * g0[1]); o.y = pk2(s[2 * 33] * g0[2], s[3 * 33] * g0[3]); o.z = pk2(s[4 * 33] * g1[0], s[5 * 33] * g1[1]); o.w = pk2(s[6 * 33] * g1[2], s[7 * 33] * g1[3]);
        *(GAS v4u*)(WT + (size_t)(n0 + n) * K + k0 + 8 * c) = o; }
    LDS_WAIT(); asm volatile("" ::: "memory");
}

struct Args { const float* in[11]; float* out; unsigned char* ws; int ph_lo, ph_hi; };

__device__ __forceinline__ void p0_prologue(const Args& a, LAS unsigned char* lds, int wave, int lane) {
    LAS float* scr = (LAS float*)(lds + wave * 16384);
    const int gw = blockIdx.x * NWAVES + wave, NGW = gridDim.x * NWAVES;
    constexpr int I_A = (D_MODEL / 64) * (NA_IN / 32), I_B = (D_MODEL / 64) * (NB_IN / 32), I_O = (D_INNER / 64) * (D_MODEL / 32);
    constexpr int NITEMS = 2 * I_A + 2 * I_B + 4 * I_O;
    const float* norm_g = a.in[1];
    for (int it = gw; it < NITEMS; it += NGW) {
        int r = it;
        if (r < 2 * I_A) { const int j = r / I_A; r -= j * I_A;
            p0_transpose_item(a.in[3] + (size_t)j * D_MODEL * NA_IN, norm_g + (2 * j) * D_MODEL, D_MODEL, NA_IN, (bf16*)(a.ws + WS_WA_IN) + (size_t)j * NA_IN * D_MODEL, 0, scr, r, lane); continue; }
        r -= 2 * I_A;
        if (r < 2 * I_B) { const int j = r / I_B; r -= j * I_B;
            p0_transpose_item(a.in[8] + (size_t)j * D_MODEL * NB_IN, norm_g + (2 * j + 1) * D_MODEL, D_MODEL, NB_IN, (bf16*)(a.ws + WS_WB_IN) + (size_t)j * NB_IN * D_MODEL, 1, scr, r, lane); continue; }
        r -= 2 * I_B;
        if (r < 2 * I_O) { const int j = r / I_O; r -= j * I_O;
            p0_transpose_item(a.in[7] + (size_t)j * D_INNER * D_MODEL, nullptr, D_INNER, D_MODEL, (bf16*)(a.ws + WS_WA_OUT) + (size_t)j * D_MODEL * D_INNER, 2, scr, r, lane); continue; }
        r -= 2 * I_O;
        { const int j = r / I_O; r -= j * I_O;
            p0_transpose_item(a.in[10] + (size_t)j * D_INNER * D_MODEL, nullptr, D_INNER, D_MODEL, (bf16*)(a.ws + WS_WB_OUT) + (size_t)j * D_MODEL * D_INNER, 2, scr, r, lane); }
    }
    const float* x = a.in[0]; bf16* XB = (bf16*)(a.ws + WS_XB); float* ssp = (float*)(a.ws + WS_SSP);
    for (int m = gw; m < M_TOK; m += NGW) {
        const GAS f32x4* xr = (const GAS f32x4*)(x + (size_t)m * D_MODEL) + lane;
        GAS unsigned long long* o8 = (GAS unsigned long long*)(XB + (size_t)m * D_MODEL) + lane;
        float s = 0.f;
#pragma unroll
        for (int j = 0; j < 4; ++j) { const f32x4 v = __builtin_nontemporal_load(xr + 64 * j); s += (v.x * v.x + v.y * v.y) + (v.z * v.z + v.w * v.w);
            o8[64 * j] = (unsigned long long)pk2(v.x, v.y) | ((unsigned long long)pk2(v.z, v.w) << 32); }
        s = wave_sum(s);
        if (lane < 16) ssp[(size_t)m * 16 + lane] = lane == 0 ? s : 0.f;
    }
}

__device__ __forceinline__ int swz4(int r) { return ((r & 7) ^ ((r >> 3) & 7)) | (r & 8); }
__device__ __forceinline__ void mixA_phase(const Args& a, int j, LAS unsigned char* lds, int tid, int wave, int lane, int dry) {
    const float* w_s = a.in[5] + (size_t)j * A_GROUPS * CHUNK * CHUNK; const float* b_s = a.in[6] + (size_t)j * A_GROUPS * CHUNK;
    bf16* UZ = (bf16*)(a.ws + WS_UZ); const bf16* V = (const bf16*)(a.ws + WS_V); const float* ssvp = (const float*)(a.ws + WS_SSVP);
    LAS unsigned char* WSl = lds; LAS unsigned char* VTl = lds + 32768; LAS float* rsv = (LAS float*)(lds + 98304);
    const int wr = wave >> 2, wc = wave & 3, fr = lane & 15, fq = lane >> 4;
    const int lc_low = tid & 7, i_low = (tid >> 3) & 7, wt = tid >> 2, wq = tid & 3;
    constexpr int NUNITS = (M_TOK / CHUNK) * A_GROUPS;
    v4u vr0[4], vr1[4]; f32x4 sv[2];
#define MIX_PREFETCH(un) do { const int g_ = (un) & 7, t0_ = ((un) >> 3) * CHUNK, c0_ = g_ * 256; \
        _Pragma("unroll") for (int it = 0; it < 4; ++it) { const int lc = lc_low + 8 * it, i = i_low + 8 * wave; \
            vr0[it] = *(const GAS v4u*)(V + (size_t)(t0_ + 2 * i) * D_INNER + c0_ + 8 * lc); vr1[it] = *(const GAS v4u*)(V + (size_t)(t0_ + 2 * i + 1) * D_INNER + c0_ + 8 * lc); } \
        sv[0] = *(const GAS f32x4*)(ssvp + (size_t)(t0_ + wt) * 32 + 8 * wq); sv[1] = *(const GAS f32x4*)(ssvp + (size_t)(t0_ + wt) * 32 + 8 * wq + 4); } while (0)
    int unit = (gridDim.x % 8 == 0) ? (int)((blockIdx.x % 8) * (gridDim.x / 8) + blockIdx.x / 8) : (int)blockIdx.x;
    if (unit < NUNITS) MIX_PREFETCH(unit);
    for (; unit < NUNITS; unit += gridDim.x) {
        const int g = unit & 7, ck = unit >> 3, t0 = ck * CHUNK, c0 = g * 256;
        f32x4 wraw[8];
        { const float* wrow = w_s + ((size_t)g * CHUNK + wt) * CHUNK + 32 * wq;
#pragma unroll
          for (int e = 0; e < 8; ++e) wraw[e] = *(const GAS f32x4*)(wrow + 4 * e); }
        { float s = ((sv[0][0] + sv[0][1]) + (sv[0][2] + sv[0][3])) + ((sv[1][0] + sv[1][1]) + (sv[1][2] + sv[1][3])); s += __shfl_xor(s, 1); s += __shfl_xor(s, 2);
          if (wq == 0) rsv[wt] = __builtin_amdgcn_rsqf(s * (1.0f / D_INNER) + pg8::RMS_EPS); }
#pragma unroll
        for (int it = 0; it < 4; ++it) { const int lc = lc_low + 8 * it, i = i_low + 8 * wave;
            const unsigned a0[4] = {vr0[it].x, vr0[it].y, vr0[it].z, vr0[it].w}, a1[4] = {vr1[it].x, vr1[it].y, vr1[it].z, vr1[it].w};
#pragma unroll
            for (int e = 0; e < 8; ++e) { const int ca = 8 * lc + e, c = (ca & ~31) | (((ca >> 2) & 1) << 4) | (((ca >> 3) & 3) << 2) | (ca & 3);     const unsigned lo = (e & 1) ? (a0[e >> 1] >> 16) : (a0[e >> 1] & 0xffffu), hi = (e & 1) ? (a1[e >> 1] & 0xffff0000u) : (a1[e >> 1] << 16);
                *(LAS unsigned*)(VTl + c * 256 + (((i >> 2) ^ swz4(c)) << 4) + ((i & 3) << 2)) = lo | hi; } }
        __syncthreads();
#pragma unroll
        for (int e = 0; e < 4; ++e) { const f32x4 w0 = wraw[2 * e], w1 = wraw[2 * e + 1]; const int s0 = 32 * wq + 8 * e;
            float fv[8];
#pragma unroll
            for (int k = 0; k < 4; ++k) { fv[k] = (s0 + k <= wt) ? w0[k] * rsv[s0 + k] : 0.f; fv[4 + k] = (s0 + 4 + k <= wt) ? w1[k] * rsv[s0 + 4 + k] : 0.f; }
            v4u o; o.x = pk2(fv[0], fv[1]); o.y = pk2(fv[2], fv[3]); o.z = pk2(fv[4], fv[5]); o.w = pk2(fv[6], fv[7]);
            *(LAS v4u*)(WSl + wt * 256 + (((4 * wq + e) ^ swz4(wt)) << 4)) = o; }
        float bb[4];
#pragma unroll
        for (int m = 0; m < 4; ++m) bb[m] = b_s[g * CHUNK + 64 * wr + 16 * m + fr];
        v4u uzr[4][2];
#pragma unroll
        for (int m = 0; m < 4; ++m)
#pragma unroll
            for (int h = 0; h < 2; ++h) uzr[m][h] = *(const GAS v4u*)(UZ + (size_t)(t0 + 64 * wr + 16 * m + fr) * D_INNER + c0 + 64 * wc + 32 * h + 8 * fq);
        if (unit + (int)gridDim.x < NUNITS) MIX_PREFETCH(unit + (int)gridDim.x);
        __syncthreads();
        const int nkk = wr ? 4 : 2;
#pragma unroll
        for (int nh = 0; nh < 2; ++nh) {
            f32x4 acc[4][2];
#pragma unroll
            for (int m = 0; m < 4; ++m)
#pragma unroll
                for (int n = 0; n < 2; ++n) acc[m][n] = (f32x4){0.f, 0.f, 0.f, 0.f};
            for (int kk = 0; kk < nkk; ++kk) {
                bf16x8 wf[4], vf[2];
#pragma unroll
                for (int m = 0; m < 4; ++m) { const int t = 64 * wr + 16 * m + fr; wf[m] = *(const LAS bf16x8*)(WSl + t * 256 + (((4 * kk + fq) ^ swz4(t)) << 4)); }
#pragma unroll
                for (int n = 0; n < 2; ++n) { const int c = 64 * wc + 32 * nh + 16 * n + fr; vf[n] = *(const LAS bf16x8*)(VTl + c * 256 + (((4 * kk + fq) ^ swz4(c)) << 4)); }
#pragma unroll
                for (int m = 0; m < 4; ++m)
#pragma unroll
                    for (int n = 0; n < 2; ++n) acc[m][n] = __builtin_amdgcn_mfma_f32_16x16x32_bf16(vf[n], wf[m], acc[m][n], 0, 0, 0);
            }
#pragma unroll
            for (int m = 0; m < 4; ++m) { const int t = 64 * wr + 16 * m + fr; const float bbm = bb[m]; const v4u uz = uzr[m][nh];
                v4u o; o.x = pk2(bflo(uz.x) * (acc[m][0][0] + bbm), bfhi(uz.x) * (acc[m][0][1] + bbm)); o.y = pk2(bflo(uz.y) * (acc[m][0][2] + bbm), bfhi(uz.y) * (acc[m][0][3] + bbm));
                o.z = pk2(bflo(uz.z) * (acc[m][1][0] + bbm), bfhi(uz.z) * (acc[m][1][1] + bbm)); o.w = pk2(bflo(uz.w) * (acc[m][1][2] + bbm), bfhi(uz.w) * (acc[m][1][3] + bbm));
                asm volatile("" :: "v"(o.x), "v"(o.y), "v"(o.z), "v"(o.w));
                if (!dry) *(GAS v4u*)(UZ + (size_t)(t0 + t) * D_INNER + c0 + 64 * wc + 32 * nh + 8 * fq) = o; }
        }
        __syncthreads();
    }
#undef MIX_PREFETCH
}

__device__ __forceinline__ void convB_fixup(const Args& a, int j, int pm, int tid) {
    if ((pm & 7) == 0) return;
    const float* wc = a.in[9] + (size_t)j * 3 * D_INNER; bf16* Y = (bf16*)(a.ws + WS_UZ);
    const float* PL = (const float*)(a.ws + WS_PL); const float* P0 = (const float*)(a.ws + WS_P0); const float* Q0 = (const float*)(a.ws + WS_Q0);
    const int r = tid >> 8, c = (tid & 255) * 8;
    float y[8];
#pragma unroll
    for (int h = 0; h < 2; ++h) { const int cc = c + 4 * h;
        const f32x4 w0 = *(const f32x4*)(wc + cc), w1 = *(const f32x4*)(wc + D_INNER + cc), w2 = *(const f32x4*)(wc + 2 * D_INNER + cc);
        const f32x4 l0 = *(const f32x4*)(PL + ((size_t)(pm - 1) * 2 + 0) * D_INNER + cc), l1 = *(const f32x4*)(PL + ((size_t)(pm - 1) * 2 + 1) * D_INNER + cc);
        const f32x4 p0 = *(const f32x4*)(P0 + ((size_t)pm * 2 + 0) * D_INNER + cc), p1 = *(const f32x4*)(P0 + ((size_t)pm * 2 + 1) * D_INNER + cc);
        const f32x4 q = *(const f32x4*)(Q0 + ((size_t)pm * 2 + r) * D_INNER + cc);
        const f32x4 o = r ? q * (w0 * l1 + w1 * p0 + w2 * p1) : q * (w0 * l0 + w1 * l1 + w2 * p0);
#pragma unroll
        for (int k = 0; k < 4; ++k) y[4 * h + k] = o[k]; }
    v4u o; o.x = pk2(y[0], y[1]); o.y = pk2(y[2], y[3]); o.z = pk2(y[4], y[5]); o.w = pk2(y[6], y[7]);
    *(GAS v4u*)(Y + (size_t)(pm * 256 + r) * D_INNER + c) = o;
}

#define CW_TEAM 8192
__device__ __forceinline__ void team_barrier4(unsigned* ctl, int pm) {
    asm volatile("s_waitcnt vmcnt(0)" ::: "memory");
    __syncthreads();
    if (threadIdx.x == 0) {
        unsigned* bar = ctl + CW_BAR; unsigned* cnt = ctl + CW_TEAM + 64 * pm;
        __builtin_amdgcn_fence(__ATOMIC_RELEASE, "agent");
        asm volatile("s_waitcnt vmcnt(0)" ::: "memory");
        (void)xb_add(cnt, 1u);
        XB_SPIN(xb_ld(cnt) < 4u, bar);
        __builtin_amdgcn_fence(__ATOMIC_ACQUIRE, "agent");
        asm volatile("s_waitcnt vmcnt(0)" ::: "memory");
    }
    __syncthreads();
}
struct EpiOutFinal {
    static constexpr bool PERM = false, AFTER_DRAIN = false, PREFETCH = false, INIT_ACC = true;
    const pg8::bf16_t* XB; float* ssp; float* out; const float* fg; unsigned* ctl;
    struct Pre {};
    __device__ __forceinline__ void prep(Pre&, const pg8::Unit&, int, int, int, int) const {}
    __device__ __forceinline__ void init_acc(f32x4 (&acc)[2][2][4][2], const pg8::Unit& u, int wr, int wc, int fr, int fq) const {
        const int row0 = u.pm * pg8::BM + wr * 64 + fr, col0 = u.pn * pg8::BM + wc * 32 + 8 * fq;
#pragma unroll
        for (int ai = 0; ai < 2; ++ai) {
            v4u xo[4][2];
#pragma unroll
            for (int m = 0; m < 4; ++m)
#pragma unroll
                for (int bj = 0; bj < 2; ++bj) xo[m][bj] = *(const v4u*)(XB + (size_t)(row0 + ai * pg8::HALF + m * 16) * 1024 + col0 + bj * pg8::HALF);
#pragma unroll
            for (int m = 0; m < 4; ++m)
#pragma unroll
                for (int bj = 0; bj < 2; ++bj) { const v4u xw = xo[m][bj];
                    acc[ai][bj][m][0] = (f32x4){bflo(xw.x), bfhi(xw.x), bflo(xw.y), bfhi(xw.y)}; acc[ai][bj][m][1] = (f32x4){bflo(xw.z), bfhi(xw.z), bflo(xw.w), bfhi(xw.w)}; }
        }
    }
    __device__ __forceinline__ void operator()(const f32x4 (&acc)[2][2][4][2], const pg8::Unit& u, Pre&, int wr, int wc, int fr, int fq) const {
        const int row0 = u.pm * pg8::BM + wr * 64 + fr, col0 = u.pn * pg8::BM + wc * 32 + 8 * fq; const pg8::XorSh xs = pg8::xorsh_make();
#pragma unroll
        for (int ai = 0; ai < 2; ++ai)
#pragma unroll
            for (int m = 0; m < 4; ++m) { const int row = row0 + ai * pg8::HALF + m * 16; f32x4 sq = (f32x4){0.f, 0.f, 0.f, 0.f};
#pragma unroll
                for (int bj = 0; bj < 2; ++bj) { const f32x4 o0 = acc[ai][bj][m][0], o1 = acc[ai][bj][m][1]; sq = sq + o0 * o0; sq = sq + o1 * o1; }
                const float ss = pg8::xorsh_sum4(xs, (sq[0] + sq[1]) + (sq[2] + sq[3]));
                if (fq == 0) ssp[(size_t)row * 16 + u.pn * 4 + wc] = ss; }
        team_barrier4(ctl, u.pm);
        float rs[2][4]; pg8::load_rs8(ssp, row0, fq, rs);
        f32x4 g[2][2];
#pragma unroll
        for (int bj = 0; bj < 2; ++bj)
#pragma unroll
            for (int n = 0; n < 2; ++n) g[bj][n] = *(const f32x4*)(fg + col0 + bj * pg8::HALF + 4 * n);
#pragma unroll
        for (int ai = 0; ai < 2; ++ai)
#pragma unroll
            for (int m = 0; m < 4; ++m) { const size_t off = (size_t)(row0 + ai * pg8::HALF + m * 16) * 1024 + col0; const float r = rs[ai][m];
#pragma unroll
                for (int bj = 0; bj < 2; ++bj) { *(f32x4*)(out + off + bj * pg8::HALF) = acc[ai][bj][m][0] * r * g[bj][0]; *(f32x4*)(out + off + bj * pg8::HALF + 4) = acc[ai][bj][m][1] * r * g[bj][1]; } }
    }
};

__device__ __forceinline__ void final_phase(const Args& a, int wave, int lane, int dry) {
    const float* fg = a.in[2]; float* out = a.out; const bf16* XB = (const bf16*)(a.ws + WS_XB);
    const int gw = blockIdx.x * NWAVES + wave, NGW = gridDim.x * NWAVES;
    f32x4 g4[4];
#pragma unroll
    for (int j = 0; j < 4; ++j) g4[j] = ((const f32x4*)fg)[64 * j + lane];
    for (int m = gw; m < M_TOK; m += NGW) {
        const GAS v2u* xr = (const GAS v2u*)(XB + (size_t)m * D_MODEL) + lane;
        GAS f32x4* orow = (GAS f32x4*)(out + (size_t)m * D_MODEL) + lane;
        f32x4 v[4]; float s = 0.f;
#pragma unroll
        for (int j = 0; j < 4; ++j) { const v2u w = xr[64 * j]; v[j] = (f32x4){bflo(w.x), bfhi(w.x), bflo(w.y), bfhi(w.y)}; s += (v[j].x * v[j].x + v[j].y * v[j].y) + (v[j].z * v[j].z + v[j].w * v[j].w); }
        const float rs = __builtin_amdgcn_rsqf(wave_sum(s) * (1.0f / D_MODEL) + pg8::RMS_EPS);
#pragma unroll
        for (int j = 0; j < 4; ++j) { const f32x4 o = v[j] * rs * g4[j]; asm volatile("" :: "v"(o.x), "v"(o.y), "v"(o.z), "v"(o.w)); if (!dry) orow[64 * j] = o; }
    }
}

__global__ void __launch_bounds__(NWAVES * 64, 2) trunk_fwd(Args args) {
    extern __shared__ __attribute__((aligned(16))) unsigned char lds_raw[];
    LAS unsigned char* lds = (LAS unsigned char*)lds_raw;
    int tid = threadIdx.x, lane = tid & 63, wave = __builtin_amdgcn_readfirstlane(tid >> 6);
#define RELOAD_TID() do { tid = threadIdx.x; asm volatile("" : "+v"(tid)); lane = tid & 63; wave = __builtin_amdgcn_readfirstlane(tid >> 6); } while (0)
    const int lo = args.ph_lo, hi = args.ph_hi;
    const int G = gridDim.x;
#define IN(k) (lo <= (k) && (k) < hi)
#define SEAM(k) do { if (IN(k) && IN((k) + 1)) xcd_barrier(bar); } while (0)
    unsigned char* ws = args.ws;
    volatile LAS unsigned* MISC = (volatile LAS unsigned*)(lds + MISC_OFF);
    if (tid < 32) MISC[tid] = 0u;
    __syncthreads();
    XcdBarrier bar = xcd_barrier_post((unsigned*)(ws + WS_CTL) + CW_BAR, MISC + 8);
    bf16* XB = (bf16*)(ws + WS_XB); float* ssp = (float*)(ws + WS_SSP); float* ssvp = (float*)(ws + WS_SSVP);
    bf16* UZ = (bf16*)(ws + WS_UZ); bf16* V = (bf16*)(ws + WS_V);

#if PROBE_PHASE >= 0
#define PROBE_MATCH(k) ((k) == 0 ? PROBE_PHASE == 6 : (k) == 13 ? PROBE_PHASE == 7 : (((k) - 1) % 6) == PROBE_PHASE)
#define REPS(k) _Pragma("unroll 1") for (int rep = PROBE_MATCH(k) ? 0 : 1; rep < 2; ++rep)
#define DRY (rep == 0)
#else
#define REPS(k)
#define DRY 0
#endif
    const bool fuse_final = MK_ONE_LAUNCH && (PROBE_PHASE < 0) && (G == 256);
    if (hi > N_PHASES) cg::this_grid().sync();
    if (IN(0)) { REPS(0) { p0_prologue(args, lds, wave, lane); __syncthreads(); } }
    SEAM(0);
#pragma unroll 1
    for (int l = 0; l < DEPTH; ++l) {
        const int j = l >> 1, pb = 1 + 3 * l;
        if ((l & 1) == 0) {
            if (IN(pb)) REPS(pb) {
                pg8::Gemm g{XB, (const bf16*)(ws + WS_WA_IN) + (size_t)j * NA_IN * D_MODEL, M_TOK, NA_IN, D_MODEL}; pg8::StaticOrder S; S.init(M_TOK, NA_IN, G, (int)blockIdx.x);
                pg8::EpiA1 E{ssp, UZ, V, ssvp, args.in[4] + (size_t)j * D_INNER, (LAS float*)(lds + RS_OFF)};
                pg8::gemm_phase<pg8::EpiA1, pg8::StaticOrder, true, true>(lds, g, S, E);
            }
            SEAM(pb);
            if (IN(pb + 1)) REPS(pb + 1) { RELOAD_TID(); mixA_phase(args, j, lds, tid, wave, lane, DRY); }
            SEAM(pb + 1);
        } else {
            if (IN(pb)) REPS(pb) {
                pg8::Gemm g{XB, (const bf16*)(ws + WS_WB_IN) + (size_t)j * NB_IN * D_MODEL, M_TOK, NB_IN, D_MODEL}; pg8::StaticOrder S; S.init(M_TOK, NB_IN, G, (int)blockIdx.x);
                pg8::EpiB1 E{ssp, UZ, args.in[9] + (size_t)j * 3 * D_INNER, (float*)(ws + WS_PL), (float*)(ws + WS_P0), (float*)(ws + WS_Q0), (LAS float*)(lds + EXCH_OFF), (LAS float*)(lds + RS_OFF), DRY ? PROBE_DRYMODE : 0};
                pg8::gemm_phase<pg8::EpiB1, pg8::StaticOrder, true, true>(lds, g, S, E);
            }
            SEAM(pb);
        }
        if (IN(pb + 2)) REPS(pb + 2) {
            const bool isB = (l & 1) != 0;
            pg8::Gemm g{UZ, (const bf16*)(ws + (isB ? WS_WB_OUT : WS_WA_OUT)) + (size_t)j * D_MODEL * D_INNER, M_TOK, D_MODEL, D_INNER}; pg8::StaticOrder S; S.init(M_TOK, D_MODEL, G, (int)blockIdx.x);
            if (isB) { RELOAD_TID();
                { pg8::Unit fu; int lastpm = -1; for (int i = 0; S.next(i, fu); ++i) if (fu.pm != lastpm) { convB_fixup(args, j, fu.pm, tid); lastpm = fu.pm; } }
                asm volatile("s_waitcnt vmcnt(0)" ::: "memory"); __syncthreads(); }
            if (l == DEPTH - 1 && fuse_final) {
                EpiOutFinal E{XB, ssp, args.out, args.in[2], (unsigned*)(ws + WS_CTL)};
                pg8::gemm_phase<EpiOutFinal, pg8::StaticOrder, true, true>(lds, g, S, E);
            } else {
                pg8::EpiOut E{XB, ssp, DRY ? (PROBE_DRYMODE ? PROBE_DRYMODE : 1) : 0};
                pg8::gemm_phase<pg8::EpiOut, pg8::StaticOrder, false, true>(lds, g, S, E);
            }
        }
        if (!(l == DEPTH - 1 && fuse_final)) SEAM(pb + 2);
    }
    if (IN(13) && !fuse_final) REPS(13) { RELOAD_TID(); final_phase(args, wave, lane, DRY); }
#undef IN
#undef SEAM
}

extern "C" void kernel_launch(void* const* d_in, const int* in_sizes, int n_in, void* d_out, int out_size, void* d_ws, size_t ws_size, hipStream_t stream) {
    static int grid = 0;
    if (grid == 0) {
        if (n_in != 11 || in_sizes[0] != M_TOK * D_MODEL || out_size != M_TOK * D_MODEL || ws_size < WS_END) { fprintf(stderr, "kernel_launch: unexpected shapes (n_in %d, in0 %d, out %d, ws %zu); nothing launched\n", n_in, n_in > 0 ? in_sizes[0] : -1, out_size, ws_size); grid = -1; return; }
        int dev = 0, cus = 0, per_cu = 0;
        if (hipGetDevice(&dev) != hipSuccess || hipDeviceGetAttribute(&cus, hipDeviceAttributeMultiprocessorCount, dev) != hipSuccess) { fprintf(stderr, "kernel_launch: device query failed\n"); grid = -1; return; }
        if (hipFuncSetAttribute((const void*)trunk_fwd, hipFuncAttributeMaxDynamicSharedMemorySize, LDS_BYTES) != hipSuccess) { fprintf(stderr, "kernel_launch: hipFuncSetAttribute failed\n"); grid = -1; return; }
        if (hipOccupancyMaxActiveBlocksPerMultiprocessor(&per_cu, (const void*)trunk_fwd, NWAVES * 64, LDS_BYTES) != hipSuccess || per_cu < 1) { fprintf(stderr, "kernel_launch: occupancy query says %d blocks per CU\n", per_cu); per_cu = 1; }
        (void)hipGetLastError();
        grid = cus * per_cu;
        fprintf(stderr, "kernel_launch: grid %d (cus %d x %d)\n", grid, cus, per_cu);
    }
    if (grid < 0) return;
    if (hipMemsetAsync((char*)d_ws + WS_CTL, 0, CTL_ZERO_BYTES, stream) != hipSuccess) { fprintf(stderr, "kernel_launch: hipMemsetAsync failed\n"); return; }
    Args a{};
    for (int i = 0; i < 11; ++i) a.in[i] = (const float*)d_in[i];
    a.out = (float*)d_out; a.ws = (unsigned char*)d_ws;
#if MK_ONE_LAUNCH
    a.ph_lo = 0; a.ph_hi = N_PHASES;
    void* kargs[] = {&a};
    hipError_t e = hipLaunchCooperativeKernel((const void*)trunk_fwd, dim3(grid), dim3(NWAVES * 64), kargs, LDS_BYTES, stream);
    if (e != hipSuccess) fprintf(stderr, "kernel_launch: cooperative launch failed: %s (grid %d)\n", hipGetErrorString(e), grid);
#else
    for (int p = 0; p < N_PHASES; ++p) { a.ph_lo = p; a.ph_hi = p + 1;
        hipLaunchKernelGGL(trunk_fwd, dim3(grid), dim3(NWAVES * 64), LDS_BYTES, stream, a);
        const hipError_t le = hipPeekAtLastError(); if (le != hipSuccess) { fprintf(stderr, "kernel_launch: launch %d failed: %s\n", p, hipGetErrorName(le)); break; } }
#endif
}
```

```cpp
#include <hip/hip_runtime.h>
#include <hip/hip_cooperative_groups.h>
#include <cstdio>
#include <cstdint>
namespace pg8 {
#define PG8_LAS __attribute__((address_space(3)))
typedef unsigned short bf16_t;
typedef short bf16x8 __attribute__((ext_vector_type(8)));
typedef float f32x4 __attribute__((ext_vector_type(4)));
typedef unsigned u32x4 __attribute__((ext_vector_type(4)));
constexpr int BM = 256, BK = 64, HALF = 128, HTB = HALF * BK * 2  , STAGE_BYTES = 8 * HTB, NXCD = 8, WGM = 8;

__host__ __device__ __forceinline__ int lds_byte(int r, int c) { const int st = (r >> 4) * 2 + (c >> 5), rr = r & 15, cc = c & 31, ob = rr * 64 + cc * 2; return st * 1024 + (ob ^ (((ob >> 9) & 1) << 5)); }
__host__ __device__ __forceinline__ void stage_rc(int b, int& R, int& C) { const int st = b / 1024, sb = b % 1024, swz = sb ^ (((sb >> 9) & 1) << 5); R = (st >> 1) * 16 + swz / 64; C = (st & 1) * 32 + (swz % 64) / 2; }
__host__ __device__ __forceinline__ int perm32(int rho) { const int n = rho >> 4, i = rho & 15; return 8 * (i >> 2) + 4 * n + (i & 3); }

struct Unit { int pm, pn; };
struct Gemm { const bf16_t* A; const bf16_t* Bt; int M, N, K; };

struct StaticOrder {
    int nM, nN, nwg, G, c;
    __host__ __device__ void init(int M, int N, int G_, int c_) { nM = M / BM; nN = N / BM; nwg = nM * nN; G = G_; c = c_; }
    __host__ __device__ bool next(int i, Unit& u) const {
        const long L = (long)i * G + c; if (L >= nwg) return false;
        int wgid = (int)L; { const int q = nwg / NXCD, r = nwg % NXCD, xcd = wgid % NXCD, off = wgid / NXCD; wgid = (xcd < r ? xcd * (q + 1) : r * (q + 1) + (xcd - r) * q) + off; }
        const int nig = WGM * nN, gid = wgid / nig, fm = gid * WGM, gsz = (nM - fm) < WGM ? (nM - fm) : WGM;
        u.pm = fm + ((wgid % nig) % gsz); u.pn = (wgid % nig) / gsz; return true;
    }
    __device__ __forceinline__ void a_ready(const Unit&) const {}
    __device__ __forceinline__ void done(const Unit&) const {}
};
__device__ __forceinline__ unsigned cvt_pk_bf16(float lo, float hi) { unsigned r; asm volatile("v_cvt_pk_bf16_f32 %0, %1, %2" : "=v"(r) : "v"(lo), "v"(hi)); return r; }

typedef unsigned u32x2 __attribute__((ext_vector_type(2)));
constexpr float RMS_EPS = 1e-6f;
__device__ __forceinline__ float silu_f(float z) { return z * __builtin_amdgcn_rcpf(1.0f + __expf(-z)); }
__device__ __forceinline__ float gate_f(float z, float c1, float rs2) { return rs2 * __builtin_amdgcn_rcpf(1.0f + __builtin_amdgcn_exp2f(z * c1)); }
__device__ __forceinline__ f32x4 gate4(f32x4 z, float c1, float rs2) {
    const f32x4 zc = z * c1; f32x4 e;
    e[0] = __builtin_amdgcn_exp2f(zc[0]); e[1] = __builtin_amdgcn_exp2f(zc[1]); e[2] = __builtin_amdgcn_exp2f(zc[2]); e[3] = __builtin_amdgcn_exp2f(zc[3]);
    const f32x4 d = e + 1.0f; f32x4 r;
    r[0] = __builtin_amdgcn_rcpf(d[0]); r[1] = __builtin_amdgcn_rcpf(d[1]); r[2] = __builtin_amdgcn_rcpf(d[2]); r[3] = __builtin_amdgcn_rcpf(d[3]);
    return r * rs2;
}
__device__ __forceinline__ float row_rs16(const float* ssp, int row) {
    const f32x4* sp = (const f32x4*)(ssp + (size_t)row * 16);
    const f32x4 a = sp[0], b = sp[1], c = sp[2], d = sp[3];
    const float s = ((a[0] + a[1]) + (a[2] + a[3])) + ((b[0] + b[1]) + (b[2] + b[3])) + ((c[0] + c[1]) + (c[2] + c[3])) + ((d[0] + d[1]) + (d[2] + d[3]));
    return __builtin_amdgcn_rsqf(s * (1.0f / 1024.0f) + RMS_EPS);
}

struct XorSh { int a16, a32; };
__device__ __forceinline__ XorSh xorsh_make() { const int l = (int)__builtin_amdgcn_mbcnt_hi(~0u, __builtin_amdgcn_mbcnt_lo(~0u, 0u)); XorSh x; x.a16 = (l ^ 16) << 2; x.a32 = (l ^ 32) << 2; return x; }
__device__ __forceinline__ float xorsh_sum4(const XorSh& x, float v) {
    v += __builtin_bit_cast(float, __builtin_amdgcn_ds_bpermute(x.a16, __builtin_bit_cast(int, v)));
    v += __builtin_bit_cast(float, __builtin_amdgcn_ds_bpermute(x.a32, __builtin_bit_cast(int, v)));
    return v;
}
__device__ __forceinline__ void load_rs8(const float* ssp, int row0, int fq, float (&rs)[2][4]) {
    f32x4 t[2][4];
#pragma unroll
    for (int ai = 0; ai < 2; ++ai)
#pragma unroll
        for (int m = 0; m < 4; ++m) t[ai][m] = *(const f32x4*)(ssp + (size_t)(row0 + ai * HALF + m * 16) * 16 + 4 * fq);
#pragma unroll
    for (int ai = 0; ai < 2; ++ai)
#pragma unroll
        for (int m = 0; m < 4; ++m) { float s = (t[ai][m][0] + t[ai][m][1]) + (t[ai][m][2] + t[ai][m][3]); s += __shfl_xor(s, 16); s += __shfl_xor(s, 32);
            rs[ai][m] = __builtin_amdgcn_rsqf(s * (1.0f / 1024.0f) + RMS_EPS); }
}

__device__ __forceinline__ void rs_to_lds(const float* ssp, PG8_LAS float* RS, const Unit& u, int wr, int wc, int fr, int fq) {
    float rs[2][4]; load_rs8(ssp, u.pm * BM + wr * 64 + fr, fq, rs);
    if (wc == 0 && fq == 0) {
#pragma unroll
        for (int ai = 0; ai < 2; ++ai)
#pragma unroll
            for (int m = 0; m < 4; ++m) RS[ai * HALF + wr * 64 + m * 16 + fr] = rs[ai][m]; }
}
__device__ __forceinline__ void rs_from_lds(const float* ssp, const PG8_LAS float* RS, bool cached, const Unit& u, int wr, int fr, int fq, float (&rs)[2][4]) {
    if (cached) {
#pragma unroll
        for (int ai = 0; ai < 2; ++ai)
#pragma unroll
            for (int m = 0; m < 4; ++m) rs[ai][m] = RS[ai * HALF + wr * 64 + m * 16 + fr];
    } else load_rs8(ssp, u.pm * BM + wr * 64 + fr, fq, rs);
}

struct EpiA1 {
    static constexpr bool PERM = false, AFTER_DRAIN = false, PREFETCH = false, INIT_ACC = false;
    const float* ssp; bf16_t* UZ; bf16_t* V; float* ssvp; const float* gv; PG8_LAS float* RS;
    struct Pre { int pm; };
    __device__ __forceinline__ void prep(Pre& p, const Unit& u, int wr, int wc, int fr, int fq) const { p.pm = u.pm; rs_to_lds(ssp, RS, u, wr, wc, fr, fq); }
    __device__ __forceinline__ void operator()(const f32x4 (&acc)[2][2][4][2], const Unit& u, Pre& pre, int wr, int wc, int fr, int fq) const {
        const int row0 = u.pm * BM + wr * 64 + fr;
        float rsa[2][4]; rs_from_lds(ssp, RS, u.pm == pre.pm, u, wr, fr, fq, rsa);
        if (u.pn < 16) {
            const int col0 = 128 * u.pn + 32 * wc + 8 * fq;
#pragma unroll
            for (int ai = 0; ai < 2; ++ai)
#pragma unroll
                for (int m = 0; m < 4; ++m) { const int row = row0 + ai * HALF + m * 16; const float rs = rsa[ai][m], rs2 = rs * rs, c1 = rs * -1.4426950408889634f;
                    const f32x4 o0 = (acc[ai][0][m][0] * acc[ai][1][m][0]) * gate4(acc[ai][1][m][0], c1, rs2), o1 = (acc[ai][0][m][1] * acc[ai][1][m][1]) * gate4(acc[ai][1][m][1], c1, rs2);
                    u32x4 w; w.x = cvt_pk_bf16(o0[0], o0[1]); w.y = cvt_pk_bf16(o0[2], o0[3]); w.z = cvt_pk_bf16(o1[0], o1[1]); w.w = cvt_pk_bf16(o1[2], o1[3]);
                    *(u32x4*)(UZ + (size_t)row * 2048 + col0) = w; }
        } else {
            const int g = u.pn - 16, col0 = 256 * g + 32 * wc + 8 * fq; const XorSh xs = xorsh_make();
            f32x4 gvv[2][2];
#pragma unroll
            for (int bj = 0; bj < 2; ++bj)
#pragma unroll
                for (int n = 0; n < 2; ++n) gvv[bj][n] = *(const f32x4*)(gv + col0 + 128 * bj + 4 * n);
#pragma unroll
            for (int ai = 0; ai < 2; ++ai)
#pragma unroll
                for (int m = 0; m < 4; ++m) { const int row = row0 + ai * HALF + m * 16; const float rs = rsa[ai][m];
                    f32x4 sq = (f32x4){0.f, 0.f, 0.f, 0.f};
#pragma unroll
                    for (int bj = 0; bj < 2; ++bj) { f32x4 v0 = acc[ai][bj][m][0] * rs, v1 = acc[ai][bj][m][1] * rs;
                        sq = sq + v0 * v0; sq = sq + v1 * v1;
                        v0 = v0 * gvv[bj][0]; v1 = v1 * gvv[bj][1];
                        u32x4 w; w.x = cvt_pk_bf16(v0[0], v0[1]); w.y = cvt_pk_bf16(v0[2], v0[3]); w.z = cvt_pk_bf16(v1[0], v1[1]); w.w = cvt_pk_bf16(v1[2], v1[3]);
                        *(u32x4*)(V + (size_t)row * 2048 + col0 + 128 * bj) = w; }
                    const float ss = xorsh_sum4(xs, (sq[0] + sq[1]) + (sq[2] + sq[3]));
                    if (fq == 0) ssvp[(size_t)row * 32 + g * 4 + wc] = ss; }
        }
    }
};

__device__ __forceinline__ float dpp_f(float old, float src, const int ctrl_sel) {
    const int o = __builtin_bit_cast(int, old), v = __builtin_bit_cast(int, src); int r;
    if (ctrl_sel == 0) r = __builtin_amdgcn_update_dpp(o, v, 0x111, 0xf, 0xf, false);
    else if (ctrl_sel == 1) r = __builtin_amdgcn_update_dpp(o, v, 0x112, 0xf, 0xf, false);
    else if (ctrl_sel == 2) r = __builtin_amdgcn_update_dpp(o, v, 0x121, 0xf, 0xf, false);
    else r = __builtin_amdgcn_update_dpp(o, v, 0x122, 0xf, 0xf, false);
    return __builtin_bit_cast(float, r);
}
__device__ __forceinline__ float dpp_ror(float src, const int n) {
    const int v = __builtin_bit_cast(int, src);
    const int r = (n == 1) ? __builtin_amdgcn_mov_dpp(v, 0x121, 0xf, 0xf, false) : __builtin_amdgcn_mov_dpp(v, 0x122, 0xf, 0xf, false);
    return __builtin_bit_cast(float, r);
}
struct EpiB1 {
    static constexpr bool PERM = false, AFTER_DRAIN = false, PREFETCH = false, INIT_ACC = false;
    const float* ssp; bf16_t* Y; const float* wconv; float* PL; float* P0; float* Q0; PG8_LAS float* X; PG8_LAS float* RS; int dry;
    struct Pre { int pm; };
    __device__ __forceinline__ void prep(Pre& p, const Unit& u, int wr, int wc, int fr, int fq) const { p.pm = u.pm; rs_to_lds(ssp, RS, u, wr, wc, fr, fq); }
    __device__ __forceinline__ void operator()(const f32x4 (&acc)[2][2][4][2], const Unit& u, Pre& pre, int wr, int wc, int fr, int fq) const {
        if (dry == 2) return;
        const int row0 = u.pm * BM + wr * 64 + fr, c4 = 64 * u.pn + 16 * wc + 4 * fq;
        float rsa[2][4]; rs_from_lds(ssp, RS, u.pm == pre.pm, u, wr, fr, fq, rsa);
        const bool seq_start = (u.pm & 7) == 0;
        const f32x4 w0 = *(const f32x4*)(wconv + c4), w1 = *(const f32x4*)(wconv + 2048 + c4), w2 = *(const f32x4*)(wconv + 4096 + c4);
#pragma unroll
        for (int ai = 0; ai < 2; ++ai) { const float rs = rsa[ai][3]; const f32x4 p3 = acc[ai][1][3][0] * acc[ai][1][3][1] * (rs * rs);
            if (fr >= 14) { *(PG8_LAS f32x4*)(X + (((((ai * 2 + wr) * 4 + wc) * 2 + (fr - 14)) * 4 + fq) * 4)) = p3;
                if (ai == 1 && wr == 1 && !dry) *(f32x4*)(PL + ((size_t)u.pm * 2 + (fr - 14)) * 2048 + c4) = p3; } }
        asm volatile("s_waitcnt lgkmcnt(0)" ::: "memory"); __builtin_amdgcn_s_barrier(); asm volatile("" ::: "memory");
#pragma unroll
        for (int ai = 0; ai < 2; ++ai) {
            f32x4 carry = (f32x4){0.f, 0.f, 0.f, 0.f};
            if (ai == 1 || wr == 1) { const int sai = wr ? ai : ai - 1, swr = wr ? 0 : 1; carry = *(const PG8_LAS f32x4*)(X + (((((sai * 2 + swr) * 4 + wc) * 2 + (fr & 1)) * 4 + fq) * 4)); }
#pragma unroll
            for (int m = 0; m < 4; ++m) { const int row = row0 + ai * HALF + m * 16; const float rs = rsa[ai][m], rs2 = rs * rs, c1 = rs * -1.4426950408889634f;
                const f32x4 p = acc[ai][1][m][0] * acc[ai][1][m][1] * rs2;
                const f32x4 q = (acc[ai][0][m][0] * acc[ai][0][m][1]) * gate4(acc[ai][0][m][1], c1, rs2);
                f32x4 pv1, pv2;
#pragma unroll
                for (int j = 0; j < 4; ++j) { pv1[j] = dpp_f(dpp_ror(carry[j], 1), p[j], 0); pv2[j] = dpp_f(dpp_ror(carry[j], 2), p[j], 1); }
                const f32x4 y = q * (w0 * pv2 + (w1 * pv1 + w2 * p));
                carry = p;
                const bool raw = (ai == 0) && (m == 0) && (wr == 0) && !seq_start && (fr < 2);
                u32x2 w; w.x = cvt_pk_bf16(y[0], y[1]); w.y = cvt_pk_bf16(y[2], y[3]);
                asm volatile("" :: "v"(w.x), "v"(w.y));
                if (!dry) { if (raw) { *(f32x4*)(P0 + ((size_t)u.pm * 2 + fr) * 2048 + c4) = p; *(f32x4*)(Q0 + ((size_t)u.pm * 2 + fr) * 2048 + c4) = q; }
                            else *(u32x2*)(Y + (size_t)row * 2048 + c4) = w; } }
        }
    }
};

__device__ __forceinline__ float bf_lo(unsigned w) { return __builtin_bit_cast(float, w << 16); }
__device__ __forceinline__ float bf_hi(unsigned w) { return __builtin_bit_cast(float, w & 0xffff0000u); }
struct EpiOut {
    static constexpr bool PERM = false, AFTER_DRAIN = false;
    bf16_t* XB; float* ssp; int dry;
    static constexpr bool PREFETCH = false, INIT_ACC = true;
    struct Pre {};
    __device__ __forceinline__ void prep(Pre&, const Unit&, int, int, int, int) const {}
    __device__ __forceinline__ void prefetch(const Unit& u, PG8_LAS unsigned char* pf, int tid, int wid) const {
#pragma unroll
        for (int i = 0; i < 2; ++i) { const int L = tid + 512 * i, row = L >> 2, seg = L & 3;
            __builtin_amdgcn_global_load_lds((const unsigned*)(XB + (size_t)(u.pm * BM + row) * 1024 + u.pn * BM + seg * 64), (PG8_LAS unsigned*)(pf + wid * 256 + i * 2048), 4, 0, 0); }
    }
    __device__ __forceinline__ void init_acc(f32x4 (&acc)[2][2][4][2], const Unit& u, int wr, int wc, int fr, int fq) const {
        const int row0 = u.pm * BM + wr * 64 + fr, col0 = u.pn * BM + wc * 32 + 8 * fq;
#pragma unroll
        for (int ai = 0; ai < 2; ++ai) {
            u32x4 xo[4][2];
#pragma unroll
            for (int m = 0; m < 4; ++m)
#pragma unroll
                for (int bj = 0; bj < 2; ++bj) xo[m][bj] = *(const u32x4*)(XB + (size_t)(row0 + ai * HALF + m * 16) * 1024 + col0 + bj * HALF);
#pragma unroll
            for (int m = 0; m < 4; ++m)
#pragma unroll
                for (int bj = 0; bj < 2; ++bj) { const u32x4 xw = xo[m][bj];
                    acc[ai][bj][m][0] = (f32x4){bf_lo(xw.x), bf_hi(xw.x), bf_lo(xw.y), bf_hi(xw.y)}; acc[ai][bj][m][1] = (f32x4){bf_lo(xw.z), bf_hi(xw.z), bf_lo(xw.w), bf_hi(xw.w)}; }
        }
    }
    __device__ __forceinline__ void operator()(const f32x4 (&acc)[2][2][4][2], const Unit& u, Pre&, int wr, int wc, int fr, int fq) const {
        if (dry == 2) return;
        const int row0 = u.pm * BM + wr * 64 + fr, col0 = u.pn * BM + wc * 32 + 8 * fq; const XorSh xs = xorsh_make();
#pragma unroll
        for (int ai = 0; ai < 2; ++ai)
#pragma unroll
            for (int m = 0; m < 4; ++m) { const int row = row0 + ai * HALF + m * 16; const size_t off = (size_t)row * 1024 + col0; f32x4 sq = (f32x4){0.f, 0.f, 0.f, 0.f};
#pragma unroll
                for (int bj = 0; bj < 2; ++bj) { const f32x4 o0 = acc[ai][bj][m][0], o1 = acc[ai][bj][m][1];
                    sq = sq + o0 * o0; sq = sq + o1 * o1;
                    u32x4 w; w.x = cvt_pk_bf16(o0[0], o0[1]); w.y = cvt_pk_bf16(o0[2], o0[3]); w.z = cvt_pk_bf16(o1[0], o1[1]); w.w = cvt_pk_bf16(o1[2], o1[3]);
                    asm volatile("" :: "v"(w.x), "v"(w.y), "v"(w.z), "v"(w.w));
                    if (!dry) *(u32x4*)(XB + off + bj * HALF) = w; }
                const float ss = xorsh_sum4(xs, (sq[0] + sq[1]) + (sq[2] + sq[3]));
                if (fq == 0 && !dry) ssp[(size_t)row * 16 + u.pn * 4 + wc] = ss; }
    }
};

template <class Epi, class Sched, bool ALIGN_EPI = false, bool SP2 = false>
__device__ __forceinline__ void gemm_phase(PG8_LAS unsigned char* lds, const Gemm g, const Sched& S, const Epi& E) {
    int tid_l = threadIdx.x; asm volatile("" : "+v"(tid_l));
    const int tid = tid_l, wid = __builtin_amdgcn_readfirstlane(tid >> 6), lane = tid & 63, wr = wid >> 2, wc = wid & 3, fr = lane & 15, fq = lane >> 4;
    const int K = g.K, nt = K / BK;
    unsigned voffA[2], voffB[2];
#pragma unroll
    for (int i = 0; i < 2; ++i) { int R, C; stage_rc(tid * 16 + i * 8192, R, C); const int Rb = Epi::PERM ? ((R & ~31) + perm32(R & 31)) : R;
        voffA[i] = (unsigned)(R * K + C) * 2u; voffB[i] = (unsigned)(Rb * K + C) * 2u; }
    const size_t kstep = (size_t)(BK * 2);
    const size_t hstep = (size_t)HALF * K * 2;
    const size_t tstep = 2 * hstep;
    const unsigned ldsw = (unsigned)wid * 1024u;
    const int aoff = lds_byte(wr * 64 + fr, fq * 8), boff = lds_byte(wc * 32 + fr, fq * 8);
#define PG8_SA(b, h) (((b) * 2 + (h)) * HTB)
#define PG8_SB(b, h) ((4 + (b) * 2 + (h)) * HTB)
#define PG8_STAGE(bufoff, gbase, voff) do { _Pragma("unroll") for (int _i = 0; _i < 2; ++_i) \
        __builtin_amdgcn_global_load_lds((const unsigned*)((const char*)(gbase) + (voff)[_i]), (PG8_LAS unsigned*)(lds + (bufoff) + ldsw + _i * 8192), 16, 0, 0); } while (0)
#define PG8_LDA(dst, b, h) do { _Pragma("unroll") for (int m = 0; m < 4; ++m) _Pragma("unroll") for (int k = 0; k < 2; ++k) dst[m][k] = *(const PG8_LAS bf16x8*)(lds + PG8_SA(b, h) + aoff + m * 2048 + k * 1024); } while (0)
#define PG8_LDB(dst, b, h) do { _Pragma("unroll") for (int n = 0; n < 2; ++n) _Pragma("unroll") for (int k = 0; k < 2; ++k) dst[n][k] = *(const PG8_LAS bf16x8*)(lds + PG8_SB(b, h) + boff + n * 2048 + k * 1024); } while (0)
#define PG8_MMA(ai, bj, At, Bt) do { __builtin_amdgcn_s_setprio(1); _Pragma("unroll") for (int m = 0; m < 4; ++m) _Pragma("unroll") for (int n = 0; n < 2; ++n) _Pragma("unroll") for (int k = 0; k < 2; ++k) \
        acc[ai][bj][m][n] = __builtin_amdgcn_mfma_f32_16x16x32_bf16(Bt[n][k], At[m][k], acc[ai][bj][m][n], 0, 0, 0); __builtin_amdgcn_s_setprio(0); } while (0)
#define PG8_WAIT_V(n) asm volatile("s_waitcnt vmcnt(" #n ")" ::: "memory")
#define PG8_WAIT_L(n) asm volatile("s_waitcnt lgkmcnt(" #n ")" ::: "memory")
#define PG8_BAR __builtin_amdgcn_s_barrier()
#define PG8_SCHED __builtin_amdgcn_sched_barrier(0)
    Unit cur, nxt; int ui = 0;
    if (!S.next(0, cur)) return;
    f32x4 acc[2][2][4][2];
    if constexpr (Epi::INIT_ACC) E.init_acc(acc, cur, wr, wc, fr, fq);
    else {
#pragma unroll
    for (int a = 0; a < 2; ++a)
#pragma unroll
        for (int b = 0; b < 2; ++b)
#pragma unroll
            for (int m = 0; m < 4; ++m)
#pragma unroll
                for (int n = 0; n < 2; ++n) acc[a][b][m][n] = (f32x4){0.f, 0.f, 0.f, 0.f};
    }
    bf16x8 At[4][2], B0[2][2], B1[2][2];
    const char* cA = (const char*)g.A + (size_t)cur.pm * tstep; const char* cB = (const char*)g.Bt + (size_t)cur.pn * tstep;
    S.a_ready(cur);
    typename Epi::Pre pre; E.prep(pre, cur, wr, wc, fr, fq);
    if constexpr (SP2) {
        PG8_STAGE(PG8_SB(0, 0), cB, voffB); PG8_STAGE(PG8_SB(0, 1), cB + hstep, voffB); PG8_STAGE(PG8_SA(0, 0), cA, voffA); PG8_STAGE(PG8_SA(0, 1), cA + hstep, voffA);
        if (wr == 1) PG8_BAR;
        PG8_WAIT_V(2); PG8_BAR;
        PG8_STAGE(PG8_SB(1, 0), cB + kstep, voffB); PG8_STAGE(PG8_SA(1, 0), cA + kstep, voffA); PG8_STAGE(PG8_SB(1, 1), cB + hstep + kstep, voffB);
        PG8_WAIT_V(6); PG8_BAR;
    } else {
        PG8_STAGE(PG8_SB(0, 0), cB, voffB); PG8_STAGE(PG8_SA(0, 0), cA, voffA); PG8_STAGE(PG8_SB(0, 1), cB + hstep, voffB); PG8_STAGE(PG8_SA(0, 1), cA + hstep, voffA);
        if (wr == 1) PG8_BAR;
        PG8_WAIT_V(4); PG8_BAR;
        PG8_STAGE(PG8_SB(1, 0), cB + kstep, voffB); PG8_STAGE(PG8_SA(1, 0), cA + kstep, voffA); PG8_STAGE(PG8_SB(1, 1), cB + hstep + kstep, voffB);
        PG8_WAIT_V(6); PG8_BAR;
    }
    for (;;) {
        const bool has_next = S.next(ui + 1, nxt);
        const char* nA = has_next ? (const char*)g.A + (size_t)nxt.pm * tstep : cA; const char* nB = has_next ? (const char*)g.Bt + (size_t)nxt.pn * tstep : cB;
        for (int t = 0; t < nt; t += 2) {
            const bool last = (t == nt - 2);
            const char* a1 = cA + (size_t)(t + 1) * kstep;
            const char* a2 = last ? nA : cA + (size_t)(t + 2) * kstep; const char* b2 = last ? nB : cB + (size_t)(t + 2) * kstep;
            const char* a3 = a2 + kstep; const char* b3 = b2 + kstep;
            if (last && has_next) S.a_ready(nxt);
            if constexpr (Epi::PREFETCH) { if (last) E.prefetch(cur, lds + 131072 + 4096, tid, wid); }
            if constexpr (SP2) {
            PG8_LDB(B0, 0, 0); PG8_LDB(B1, 0, 1); PG8_SCHED; PG8_LDA(At, 0, 0); PG8_STAGE(PG8_SA(1, 1), a1 + hstep, voffA);
            PG8_WAIT_V(8); PG8_WAIT_L(0); PG8_BAR; PG8_MMA(0, 0, At, B0); PG8_MMA(0, 1, At, B1); PG8_BAR; PG8_SCHED;
            PG8_LDA(At, 0, 1); PG8_STAGE(PG8_SB(0, 0), b2, voffB); PG8_STAGE(PG8_SB(0, 1), b2 + hstep, voffB); PG8_STAGE(PG8_SA(0, 0), a2, voffA);
            PG8_WAIT_V(8); PG8_WAIT_L(0); PG8_BAR; PG8_MMA(1, 0, At, B0); PG8_MMA(1, 1, At, B1); PG8_BAR; PG8_SCHED;
            PG8_LDB(B0, 1, 0); PG8_LDB(B1, 1, 1); PG8_SCHED; PG8_LDA(At, 1, 0); PG8_STAGE(PG8_SA(0, 1), a2 + hstep, voffA);
            PG8_WAIT_V(8); PG8_WAIT_L(0); PG8_BAR; PG8_MMA(0, 0, At, B0); PG8_MMA(0, 1, At, B1); PG8_BAR; PG8_SCHED;
            PG8_LDA(At, 1, 1); PG8_STAGE(PG8_SB(1, 0), b3, voffB); PG8_STAGE(PG8_SB(1, 1), b3 + hstep, voffB); PG8_STAGE(PG8_SA(1, 0), a3, voffA);
            PG8_WAIT_V(8); PG8_WAIT_L(0); PG8_BAR; PG8_MMA(1, 0, At, B0); PG8_MMA(1, 1, At, B1); PG8_BAR; PG8_SCHED;
            } else {
            PG8_LDB(B0, 0, 0); PG8_SCHED; PG8_LDA(At, 0, 0); PG8_STAGE(PG8_SA(1, 1), a1 + hstep, voffA);
            PG8_WAIT_L(8); PG8_BAR; PG8_WAIT_L(0); PG8_MMA(0, 0, At, B0); PG8_BAR; PG8_SCHED;
            PG8_LDB(B1, 0, 1); PG8_STAGE(PG8_SB(0, 0), b2, voffB);
            PG8_BAR; PG8_WAIT_L(0); PG8_MMA(0, 1, At, B1); PG8_BAR;
            PG8_LDA(At, 0, 1); PG8_STAGE(PG8_SA(0, 0), a2, voffA);
            PG8_BAR; PG8_WAIT_L(0); PG8_MMA(1, 0, At, B0); PG8_BAR; PG8_SCHED;
            PG8_STAGE(PG8_SB(0, 1), b2 + hstep, voffB);
            PG8_WAIT_V(6); PG8_BAR; PG8_MMA(1, 1, At, B1); PG8_BAR;
            PG8_LDB(B0, 1, 0); PG8_SCHED; PG8_LDA(At, 1, 0); PG8_STAGE(PG8_SA(0, 1), a2 + hstep, voffA);
            PG8_WAIT_L(8); PG8_BAR; PG8_WAIT_L(0); PG8_MMA(0, 0, At, B0); PG8_BAR; PG8_SCHED;
            PG8_LDB(B1, 1, 1); PG8_STAGE(PG8_SB(1, 0), b3, voffB);
            PG8_BAR; PG8_WAIT_L(0); PG8_MMA(0, 1, At, B1); PG8_BAR;
            PG8_LDA(At, 1, 1); PG8_STAGE(PG8_SA(1, 0), a3, voffA);
            PG8_BAR; PG8_WAIT_L(0); PG8_MMA(1, 0, At, B0); PG8_BAR; PG8_SCHED;
            PG8_STAGE(PG8_SB(1, 1), b3 + hstep, voffB);
            PG8_WAIT_V(6); PG8_BAR; PG8_MMA(1, 1, At, B1); PG8_BAR;
            }
        }
        if constexpr (ALIGN_EPI) { if (wr == 0) PG8_BAR; }
        if constexpr (!Epi::AFTER_DRAIN) { E(acc, cur, pre, wr, wc, fr, fq); S.done(cur); }
        if (!has_next) break;
        if constexpr (Epi::INIT_ACC) E.init_acc(acc, nxt, wr, wc, fr, fq);
        else {
#pragma unroll
        for (int a = 0; a < 2; ++a)
#pragma unroll
            for (int b = 0; b < 2; ++b)
#pragma unroll
                for (int m = 0; m < 4; ++m)
#pragma unroll
                    for (int n = 0; n < 2; ++n) acc[a][b][m][n] = (f32x4){0.f, 0.f, 0.f, 0.f};
        }
        cur = nxt; cA = nA; cB = nB; ++ui;
        if constexpr (ALIGN_EPI) { if (wr == 1) PG8_BAR; }
    }
    PG8_WAIT_V(0);
    if constexpr (!ALIGN_EPI) { if (wr == 0) PG8_BAR; }
    PG8_BAR;
    if constexpr (Epi::AFTER_DRAIN) { E.fused(acc, cur, wr, wc, fr, fq, lds, wid, lane); S.done(cur); }
#undef PG8_SA
#undef PG8_SB
#undef PG8_STAGE
#undef PG8_LDA
#undef PG8_LDB
#undef PG8_MMA
#undef PG8_WAIT_V
#undef PG8_WAIT_L
#undef PG8_BAR
#undef PG8_SCHED
}
}

namespace cg = cooperative_groups;
constexpr int NWAVES = 8;
constexpr int D_MODEL = 1024, BATCH = 8, SEQ = 2048, DEPTH = 4, D_INNER = 2048, CHUNK = 128, A_GROUPS = 8;
constexpr int M_TOK = BATCH * SEQ;
constexpr int NA_IN = 3 * D_INNER, NB_IN = 4 * D_INNER;
constexpr int N_PHASES = 14;
#ifndef MK_ONE_LAUNCH
#define MK_ONE_LAUNCH 1
#endif
#ifndef PROBE_DRYMODE
#define PROBE_DRYMODE 0
#endif
#ifndef PROBE_PHASE
#define PROBE_PHASE (-1)
#endif
constexpr size_t MiB = 1u << 20;
constexpr size_t WS_CTL = 0, CTL_ZERO_BYTES = 64 * 1024;
constexpr size_t WS_WA_IN = 1 * MiB, WS_WB_IN = 25 * MiB, WS_WA_OUT = 57 * MiB, WS_WB_OUT = 65 * MiB;
constexpr size_t WS_XB = 73 * MiB;
constexpr size_t WS_SSP = 105 * MiB;
constexpr size_t WS_SSVP = 106 * MiB;
constexpr size_t WS_UZ = 108 * MiB;
constexpr size_t WS_V = 172 * MiB;
constexpr size_t WS_PL = 236 * MiB, WS_P0 = 237 * MiB, WS_Q0 = 238 * MiB;
constexpr size_t WS_END = 239 * MiB;
constexpr int RS_OFF = 131072 + 3072;
constexpr int EXCH_OFF = 131072 + 1024;
constexpr int MISC_OFF = 131072 + 320;
constexpr int CW_BAR = 4096;
constexpr int LDS_BYTES = 147456;

#define GAS __attribute__((address_space(1)))
#define LAS __attribute__((address_space(3)))
typedef unsigned short bf16;
typedef unsigned v4u __attribute__((ext_vector_type(4)));
typedef unsigned v2u __attribute__((ext_vector_type(2)));
typedef float f32x4 __attribute__((ext_vector_type(4)));
typedef short bf16x8 __attribute__((ext_vector_type(8)));
#define LDS_WAIT() asm volatile("s_waitcnt lgkmcnt(0)" ::: "memory")
__device__ __forceinline__ unsigned f2bf(float f) { unsigned u = __builtin_bit_cast(unsigned, f); return (u + 0x7fffu + ((u >> 16) & 1u)) >> 16; }
__device__ __forceinline__ unsigned pk2(float lo, float hi) { unsigned r; asm("v_cvt_pk_bf16_f32 %0, %1, %2" : "=v"(r) : "v"(lo), "v"(hi)); return r; }
__device__ __forceinline__ float bflo(unsigned w) { return __builtin_bit_cast(float, w << 16); }
__device__ __forceinline__ float bfhi(unsigned w) { return __builtin_bit_cast(float, w & 0xffff0000u); }
__device__ __forceinline__ float wave_sum(float v) {
#pragma unroll
    for (int o = 1; o < 64; o <<= 1) v += __shfl_xor(v, o);
    return v;
}

#define RLX_AGENT __ATOMIC_RELAXED, __HIP_MEMORY_SCOPE_AGENT
#define XB_TMO      128
#define XB_XCNT(j)  (256  + 64 * (j))
#define XB_XSUB(j)  (1280 + 64 * (j))
#define XB_XGEN(j)  (2304 + 64 * (j))
#define XB_TOP      3328
#define XB_TOPGEN   3392
#define XCD_BAR_WORDS 3456
#define XB_SPIN_CAP (1u << 18)

__device__ __forceinline__ unsigned xb_ld(unsigned* p)              { return __hip_atomic_load(p, __ATOMIC_RELAXED, __HIP_MEMORY_SCOPE_AGENT); }
__device__ __forceinline__ unsigned xb_add(unsigned* p, unsigned v) { return __hip_atomic_fetch_add(p, v, __ATOMIC_RELAXED, __HIP_MEMORY_SCOPE_AGENT); }
__device__ __forceinline__ unsigned xb_xcc_id() { return (unsigned)__builtin_amdgcn_s_getreg((3 << 11) | 20) & 0xFu; }
#define XB_SPIN(cond, bar) do { unsigned _sp = 0; while (cond) { __builtin_amdgcn_s_sleep(1); \
    if ((++_sp & 255u) == 0u) { if (xb_ld(&(bar)[XB_TMO])) break; if (_sp > XB_SPIN_CAP) { atomicAdd(&(bar)[XB_TMO], 1u); break; } } } } while (0)

struct XcdBarrier {
    unsigned* bar; unsigned x;
    volatile LAS unsigned* st;
};

__device__ __forceinline__ XcdBarrier xcd_barrier_post(unsigned* bar, volatile LAS unsigned* st) {
    XcdBarrier b; b.bar = bar; b.x = xb_xcc_id(); b.st = st;
    if (threadIdx.x == 0) (void)xb_add(&bar[XB_XCNT(b.x)], 1u);
    return b;
}
__device__ __forceinline__ void xcd_barrier_complete(unsigned* bar, unsigned x, unsigned& nloc, unsigned& nx) {
    const unsigned G = gridDim.x * gridDim.y * gridDim.z;
    unsigned sum, cnt, mine, sp = 0u;
    for (;;) {
        sum = 0u; cnt = 0u; mine = 0u;
#pragma unroll
        for (unsigned j = 0; j < 16; ++j) { const unsigned c = xb_ld(&bar[XB_XCNT(j)]); sum += c; cnt += (c > 0u) ? 1u : 0u; mine = (j == x) ? c : mine; }
        if (sum == G) break;
        __builtin_amdgcn_s_sleep(1);
        if ((++sp & 255u) == 0u) { if (xb_ld(&bar[XB_TMO])) break; if (sp > XB_SPIN_CAP) { atomicAdd(&bar[XB_TMO], 1u); break; } }
    }
    nloc = mine > 0u ? mine : 1u; nx = cnt > 0u ? cnt : 1u;
}

__device__ __forceinline__ void xcd_barrier(const XcdBarrier& b) {
    asm volatile("s_waitcnt vmcnt(0)" ::: "memory");
    __syncthreads();
    if (threadIdx.x == 0) {
        unsigned* bar = b.bar;
        __builtin_amdgcn_s_waitcnt(0);
        unsigned nloc = b.st[0], nx = b.st[1];
        if (nloc == 0u) { xcd_barrier_complete(bar, b.x, nloc, nx); b.st[0] = nloc; b.st[1] = nx; }
        const unsigned old = xb_add(&bar[XB_XSUB(b.x)], 1u);
        const unsigned gen = old / nloc;
        if (old + 1u == (gen + 1u) * nloc) {
            __builtin_amdgcn_fence(__ATOMIC_RELEASE, "agent");
            asm volatile("s_waitcnt vmcnt(0)" ::: "memory");
            const unsigned og = xb_add(&bar[XB_TOP], 1u);
            const unsigned tg = og / nx;
            if (og + 1u == (tg + 1u) * nx) xb_add(&bar[XB_TOPGEN], 1u);
            else XB_SPIN(xb_ld(&bar[XB_TOPGEN]) == tg, bar);
            __builtin_amdgcn_fence(__ATOMIC_ACQUIRE, "agent");
            xb_add(&bar[XB_XGEN(b.x)], 1u);
            asm volatile("s_waitcnt vmcnt(0)" ::: "memory");
        } else {
            XB_SPIN(xb_ld(&bar[XB_XGEN(b.x)]) == gen, bar);
            __builtin_amdgcn_fence(__ATOMIC_ACQUIRE, "agent");
            asm volatile("s_waitcnt vmcnt(0)" ::: "memory");
        }
    }
    __syncthreads();
}

__device__ __forceinline__ int src_col(int mode, int rho) {
    const int pn = rho >> 8, r = rho & 255, bj = r >> 7, wc = (r >> 5) & 3;
    if (mode == 0) { const int p = pg8::perm32(r & 31);
        if (pn < 16) return (bj ? 2 * D_INNER : 0) + 128 * pn + 32 * wc + p;
        return D_INNER + 256 * (pn - 16) + 128 * bj + 32 * wc + p; }
    if (mode == 1) { const int n = (r >> 4) & 1, r16 = r & 15; const int part = bj ? (n ? 2 : 1) : (n ? 3 : 0); return part * D_INNER + 64 * pn + 16 * wc + r16; }
    return (rho & ~31) + pg8::perm32(rho & 31);
}
__device__ __forceinline__ void p0_transpose_item(const float* W, const float* gain, int K, int N, bf16* WT, int mode, LAS float* scr, int item, int lane) {
    const int nblk = N / 32, kb = item / nblk, nb = item % nblk, k0 = 64 * kb, n0 = 32 * nb;
    const int sc = src_col(mode, n0 + (lane & 31));
#pragma unroll 8
    for (int i = 0; i < 32; ++i) { const int kk = 2 * i + (lane >> 5); scr[kk * 33 + (lane & 31)] = __builtin_nontemporal_load(W + (size_t)(k0 + kk) * N + sc); }
    const int c = lane & 7;
    f32x4 g0 = (f32x4){1.f, 1.f, 1.f, 1.f}, g1 = g0;
    if (gain) { g0 = *(const f32x4*)(gain + k0 + 8 * c); g1 = *(const f32x4*)(gain + k0 + 8 * c + 4); }
    LDS_WAIT(); asm volatile("" ::: "memory");
#pragma unroll
    for (int j = 0; j < 4; ++j) { const int n = (lane >> 3) + 8 * j; const LAS float* s = scr + (8 * c) * 33 + n;
        v4u o; o.x = pk2(s[0 * 33] * g0[0], s[1 * 33] * g0[1]); o.y = pk2(s[2 * 33] * g0[2], s[3 * 33] * g0[3]); o.z = pk2(s[4 * 33] * g1[0], s[5 * 33] * g1[1]); o.w = pk2(s[6 * 33] * g1[2], s[7 * 33] * g1[3]);
        *(GAS v4u*)(WT + (size_t)(n0 + n) * K + k0 + 8 * c) = o; }
    LDS_WAIT(); asm volatile("" ::: "memory");
}

struct Args { const float* in[11]; float* out; unsigned char* ws; int ph_lo, ph_hi; };

__device__ __forceinline__ void p0_prologue(const Args& a, LAS unsigned char* lds, int wave, int lane) {
    LAS float* scr = (LAS float*)(lds + wave * 16384);
    const int gw = blockIdx.x * NWAVES + wave, NGW = gridDim.x * NWAVES;
    constexpr int I_A = (D_MODEL / 64) * (NA_IN / 32), I_B = (D_MODEL / 64) * (NB_IN / 32), I_O = (D_INNER / 64) * (D_MODEL / 32);
    constexpr int NITEMS = 2 * I_A + 2 * I_B + 4 * I_O;
    const float* norm_g = a.in[1];
    for (int it = gw; it < NITEMS; it += NGW) {
        int r = it;
        if (r < 2 * I_A) { const int j = r / I_A; r -= j * I_A;
            p0_transpose_item(a.in[3] + (size_t)j * D_MODEL * NA_IN, norm_g + (2 * j) * D_MODEL, D_MODEL, NA_IN, (bf16*)(a.ws + WS_WA_IN) + (size_t)j * NA_IN * D_MODEL, 0, scr, r, lane); continue; }
        r -= 2 * I_A;
        if (r < 2 * I_B) { const int j = r / I_B; r -= j * I_B;
            p0_transpose_item(a.in[8] + (size_t)j * D_MODEL * NB_IN, norm_g + (2 * j + 1) * D_MODEL, D_MODEL, NB_IN, (bf16*)(a.ws + WS_WB_IN) + (size_t)j * NB_IN * D_MODEL, 1, scr, r, lane); continue; }
        r -= 2 * I_B;
        if (r < 2 * I_O) { const int j = r / I_O; r -= j * I_O;
            p0_transpose_item(a.in[7] + (size_t)j * D_INNER * D_MODEL, nullptr, D_INNER, D_MODEL, (bf16*)(a.ws + WS_WA_OUT) + (size_t)j * D_MODEL * D_INNER, 2, scr, r, lane); continue; }
        r -= 2 * I_O;
        { const int j = r / I_O; r -= j * I_O;
            p0_transpose_item(a.in[10] + (size_t)j * D_INNER * D_MODEL, nullptr, D_INNER, D_MODEL, (bf16*)(a.ws + WS_WB_OUT) + (size_t)j * D_MODEL * D_INNER, 2, scr, r, lane); }
    }
    const float* x = a.in[0]; bf16* XB = (bf16*)(a.ws + WS_XB); float* ssp = (float*)(a.ws + WS_SSP);
    for (int m = gw; m < M_TOK; m += NGW) {
        const GAS f32x4* xr = (const GAS f32x4*)(x + (size_t)m * D_MODEL) + lane;
        GAS unsigned long long* o8 = (GAS unsigned long long*)(XB + (size_t)m * D_MODEL) + lane;
        float s = 0.f;
#pragma unroll
        for (int j = 0; j < 4; ++j) { const f32x4 v = __builtin_nontemporal_load(xr + 64 * j); s += (v.x * v.x + v.y * v.y) + (v.z * v.z + v.w * v.w);
            o8[64 * j] = (unsigned long long)pk2(v.x, v.y) | ((unsigned long long)pk2(v.z, v.w) << 32); }
        s = wave_sum(s);
        if (lane < 16) ssp[(size_t)m * 16 + lane] = lane == 0 ? s : 0.f;
    }
}

__device__ __forceinline__ int swz4(int r) { return ((r & 7) ^ ((r >> 3) & 7)) | (r & 8); }
__device__ __forceinline__ void mixA_phase(const Args& a, int j, LAS unsigned char* lds, int tid, int wave, int lane, int dry) {
    const float* w_s = a.in[5] + (size_t)j * A_GROUPS * CHUNK * CHUNK; const float* b_s = a.in[6] + (size_t)j * A_GROUPS * CHUNK;
    bf16* UZ = (bf16*)(a.ws + WS_UZ); const bf16* V = (const bf16*)(a.ws + WS_V); const float* ssvp = (const float*)(a.ws + WS_SSVP);
    LAS unsigned char* WSl = lds; LAS unsigned char* VTl = lds + 32768; LAS float* rsv = (LAS float*)(lds + 98304);
    const int wr = wave >> 2, wc = wave & 3, fr = lane & 15, fq = lane >> 4;
    const int lc_low = tid & 7, i_low = (tid >> 3) & 7, wt = tid >> 2, wq = tid & 3;
    constexpr int NUNITS = (M_TOK / CHUNK) * A_GROUPS;
    v4u vr0[4], vr1[4]; f32x4 sv[2];
#define MIX_PREFETCH(un) do { const int g_ = (un) & 7, t0_ = ((un) >> 3) * CHUNK, c0_ = g_ * 256; \
        _Pragma("unroll") for (int it = 0; it < 4; ++it) { const int lc = lc_low + 8 * it, i = i_low + 8 * wave; \
            vr0[it] = *(const GAS v4u*)(V + (size_t)(t0_ + 2 * i) * D_INNER + c0_ + 8 * lc); vr1[it] = *(const GAS v4u*)(V + (size_t)(t0_ + 2 * i + 1) * D_INNER + c0_ + 8 * lc); } \
        sv[0] = *(const GAS f32x4*)(ssvp + (size_t)(t0_ + wt) * 32 + 8 * wq); sv[1] = *(const GAS f32x4*)(ssvp + (size_t)(t0_ + wt) * 32 + 8 * wq + 4); } while (0)
    int unit = (gridDim.x % 8 == 0) ? (int)((blockIdx.x % 8) * (gridDim.x / 8) + blockIdx.x / 8) : (int)blockIdx.x;
    if (unit < NUNITS) MIX_PREFETCH(unit);
    for (; unit < NUNITS; unit += gridDim.x) {
        const int g = unit & 7, ck = unit >> 3, t0 = ck * CHUNK, c0 = g * 256;
        f32x4 wraw[8];
        { const float* wrow = w_s + ((size_t)g * CHUNK + wt) * CHUNK + 32 * wq;
#pragma unroll
          for (int e = 0; e < 8; ++e) wraw[e] = *(const GAS f32x4*)(wrow + 4 * e); }
        v4u uzr[4][2];
#pragma unroll
        for (int m = 0; m < 4; ++m)
#pragma unroll
            for (int h = 0; h < 2; ++h) uzr[m][h] = *(const GAS v4u*)(UZ + (size_t)(t0 + 64 * wr + 16 * m + fr) * D_INNER + c0 + 64 * wc + 32 * h + 8 * fq);
        { float s = ((sv[0][0] + sv[0][1]) + (sv[0][2] + sv[0][3])) + ((sv[1][0] + sv[1][1]) + (sv[1][2] + sv[1][3])); s += __shfl_xor(s, 1); s += __shfl_xor(s, 2);
          if (wq == 0) rsv[wt] = __builtin_amdgcn_rsqf(s * (1.0f / D_INNER) + pg8::RMS_EPS); }
#pragma unroll
        for (int it = 0; it < 4; ++it) { const int lc = lc_low + 8 * it, i = i_low + 8 * wave;
            const unsigned a0[4] = {vr0[it].x, vr0[it].y, vr0[it].z, vr0[it].w}, a1[4] = {vr1[it].x, vr1[it].y, vr1[it].z, vr1[it].w};
#pragma unroll
            for (int e = 0; e < 8; ++e) { const int ca = 8 * lc + e, c = (ca & ~31) | (((ca >> 2) & 1) << 4) | (((ca >> 3) & 3) << 2) | (ca & 3);     const unsigned lo = (e & 1) ? (a0[e >> 1] >> 16) : (a0[e >> 1] & 0xffffu), hi = (e & 1) ? (a1[e >> 1] & 0xffff0000u) : (a1[e >> 1] << 16);
                *(LAS unsigned*)(VTl + c * 256 + (((i >> 2) ^ swz4(c)) << 4) + ((i & 3) << 2)) = lo | hi; } }
        __syncthreads();
#pragma unroll
        for (int e = 0; e < 4; ++e) { const f32x4 w0 = wraw[2 * e], w1 = wraw[2 * e + 1]; const int s0 = 32 * wq + 8 * e;
            float fv[8];
#pragma unroll
            for (int k = 0; k < 4; ++k) { fv[k] = (s0 + k <= wt) ? w0[k] * rsv[s0 + k] : 0.f; fv[4 + k] = (s0 + 4 + k <= wt) ? w1[k] * rsv[s0 + 4 + k] : 0.f; }
            v4u o; o.x = pk2(fv[0], fv[1]); o.y = pk2(fv[2], fv[3]); o.z = pk2(fv[4], fv[5]); o.w = pk2(fv[6], fv[7]);
            *(LAS v4u*)(WSl + wt * 256 + (((4 * wq + e) ^ swz4(wt)) << 4)) = o; }
        float bb[4];
#pragma unroll
        for (int m = 0; m < 4; ++m) bb[m] = b_s[g * CHUNK + 64 * wr + 16 * m + fr];
        if (unit + (int)gridDim.x < NUNITS) MIX_PREFETCH(unit + (int)gridDim.x);
        __syncthreads();
        const int nkk = wr ? 4 : 2;
#pragma unroll
        for (int nh = 0; nh < 2; ++nh) {
            f32x4 acc[4][2];
#pragma unroll
            for (int m = 0; m < 4; ++m)
#pragma unroll
                for (int n = 0; n < 2; ++n) acc[m][n] = (f32x4){0.f, 0.f, 0.f, 0.f};
            for (int kk = 0; kk < nkk; ++kk) {
                bf16x8 wf[4], vf[2];
#pragma unroll
                for (int m = 0; m < 4; ++m) { const int t = 64 * wr + 16 * m + fr; wf[m] = *(const LAS bf16x8*)(WSl + t * 256 + (((4 * kk + fq) ^ swz4(t)) << 4)); }
#pragma unroll
                for (int n = 0; n < 2; ++n) { const int c = 64 * wc + 32 * nh + 16 * n + fr; vf[n] = *(const LAS bf16x8*)(VTl + c * 256 + (((4 * kk + fq) ^ swz4(c)) << 4)); }
#pragma unroll
                for (int m = 0; m < 4; ++m)
#pragma unroll
                    for (int n = 0; n < 2; ++n) acc[m][n] = __builtin_amdgcn_mfma_f32_16x16x32_bf16(vf[n], wf[m], acc[m][n], 0, 0, 0);
            }
#pragma unroll
            for (int m = 0; m < 4; ++m) { const int t = 64 * wr + 16 * m + fr; const float bbm = bb[m]; const v4u uz = uzr[m][nh];
                v4u o; o.x = pk2(bflo(uz.x) * (acc[m][0][0] + bbm), bfhi(uz.x) * (acc[m][0][1] + bbm)); o.y = pk2(bflo(uz.y) * (acc[m][0][2] + bbm), bfhi(uz.y) * (acc[m][0][3] + bbm));
                o.z = pk2(bflo(uz.z) * (acc[m][1][0] + bbm), bfhi(uz.z) * (acc[m][1][1] + bbm)); o.w = pk2(bflo(uz.w) * (acc[m][1][2] + bbm), bfhi(uz.w) * (acc[m][1][3] + bbm));
                asm volatile("" :: "v"(o.x), "v"(o.y), "v"(o.z), "v"(o.w));
                if (!dry) *(GAS v4u*)(UZ + (size_t)(t0 + t) * D_INNER + c0 + 64 * wc + 32 * nh + 8 * fq) = o; }
        }
        __syncthreads();
    }
#undef MIX_PREFETCH
}

__device__ __forceinline__ void convB_fixup(const Args& a, int j, int pm, int tid) {
    if ((pm & 7) == 0) return;
    const float* wc = a.in[9] + (size_t)j * 3 * D_INNER; bf16* Y = (bf16*)(a.ws + WS_UZ);
    const float* PL = (const float*)(a.ws + WS_PL); const float* P0 = (const float*)(a.ws + WS_P0); const float* Q0 = (const float*)(a.ws + WS_Q0);
    const int r = tid >> 8, c = (tid & 255) * 8;
    float y[8];
#pragma unroll
    for (int h = 0; h < 2; ++h) { const int cc = c + 4 * h;
        const f32x4 w0 = *(const f32x4*)(wc + cc), w1 = *(const f32x4*)(wc + D_INNER + cc), w2 = *(const f32x4*)(wc + 2 * D_INNER + cc);
        const f32x4 l0 = *(const f32x4*)(PL + ((size_t)(pm - 1) * 2 + 0) * D_INNER + cc), l1 = *(const f32x4*)(PL + ((size_t)(pm - 1) * 2 + 1) * D_INNER + cc);
        const f32x4 p0 = *(const f32x4*)(P0 + ((size_t)pm * 2 + 0) * D_INNER + cc), p1 = *(const f32x4*)(P0 + ((size_t)pm * 2 + 1) * D_INNER + cc);
        const f32x4 q = *(const f32x4*)(Q0 + ((size_t)pm * 2 + r) * D_INNER + cc);
        const f32x4 o = r ? q * (w0 * l1 + w1 * p0 + w2 * p1) : q * (w0 * l0 + w1 * l1 + w2 * p0);
#pragma unroll
        for (int k = 0; k < 4; ++k) y[4 * h + k] = o[k]; }
    v4u o; o.x = pk2(y[0], y[1]); o.y = pk2(y[2], y[3]); o.z = pk2(y[4], y[5]); o.w = pk2(y[6], y[7]);
    *(GAS v4u*)(Y + (size_t)(pm * 256 + r) * D_INNER + c) = o;
}

__device__ __forceinline__ void final_phase(const Args& a, int wave, int lane, int dry) {
    const float* fg = a.in[2]; float* out = a.out; const bf16* XB = (const bf16*)(a.ws + WS_XB);
    const int gw = blockIdx.x * NWAVES + wave, NGW = gridDim.x * NWAVES;
    f32x4 g4[4];
#pragma unroll
    for (int j = 0; j < 4; ++j) g4[j] = ((const f32x4*)fg)[64 * j + lane];
    for (int m = gw; m < M_TOK; m += NGW) {
        const GAS v2u* xr = (const GAS v2u*)(XB + (size_t)m * D_MODEL) + lane;
        GAS f32x4* orow = (GAS f32x4*)(out + (size_t)m * D_MODEL) + lane;
        f32x4 v[4]; float s = 0.f;
#pragma unroll
        for (int j = 0; j < 4; ++j) { const v2u w = xr[64 * j]; v[j] = (f32x4){bflo(w.x), bfhi(w.x), bflo(w.y), bfhi(w.y)}; s += (v[j].x * v[j].x + v[j].y * v[j].y) + (v[j].z * v[j].z + v[j].w * v[j].w); }
        const float rs = __builtin_amdgcn_rsqf(wave_sum(s) * (1.0f / D_MODEL) + pg8::RMS_EPS);
#pragma unroll
        for (int j = 0; j < 4; ++j) { const f32x4 o = v[j] * rs * g4[j]; asm volatile("" :: "v"(o.x), "v"(o.y), "v"(o.z), "v"(o.w)); if (!dry) orow[64 * j] = o; }
    }
}

__global__ void __launch_bounds__(NWAVES * 64, 2) trunk_fwd(Args args) {
    extern __shared__ __attribute__((aligned(16))) unsigned char lds_raw[];
    LAS unsigned char* lds = (LAS unsigned char*)lds_raw;
    int tid = threadIdx.x, lane = tid & 63, wave = __builtin_amdgcn_readfirstlane(tid >> 6);
#define RELOAD_TID() do { tid = threadIdx.x; asm volatile("" : "+v"(tid)); lane = tid & 63; wave = __builtin_amdgcn_readfirstlane(tid >> 6); } while (0)
    const int lo = args.ph_lo, hi = args.ph_hi;
    const int G = gridDim.x;
#define IN(k) (lo <= (k) && (k) < hi)
#define SEAM(k) do { if (IN(k) && IN((k) + 1)) xcd_barrier(bar); } while (0)
    unsigned char* ws = args.ws;
    volatile LAS unsigned* MISC = (volatile LAS unsigned*)(lds + MISC_OFF);
    if (tid < 32) MISC[tid] = 0u;
    __syncthreads();
    XcdBarrier bar = xcd_barrier_post((unsigned*)(ws + WS_CTL) + CW_BAR, MISC + 8);
    bf16* XB = (bf16*)(ws + WS_XB); float* ssp = (float*)(ws + WS_SSP); float* ssvp = (float*)(ws + WS_SSVP);
    bf16* UZ = (bf16*)(ws + WS_UZ); bf16* V = (bf16*)(ws + WS_V);

#if PROBE_PHASE >= 0
#define PROBE_MATCH(k) ((k) == 0 ? PROBE_PHASE == 6 : (k) == 13 ? PROBE_PHASE == 7 : (((k) - 1) % 6) == PROBE_PHASE)
#define REPS(k) _Pragma("unroll 1") for (int rep = PROBE_MATCH(k) ? 0 : 1; rep < 2; ++rep)
#define DRY (rep == 0)
#else
#define REPS(k)
#define DRY 0
#endif
    if (hi > N_PHASES) cg::this_grid().sync();
    if (IN(0)) { REPS(0) { p0_prologue(args, lds, wave, lane); __syncthreads(); } }
    SEAM(0);
#pragma unroll 1
    for (int l = 0; l < DEPTH; ++l) {
        const int j = l >> 1, pb = 1 + 3 * l;
        if ((l & 1) == 0) {
            if (IN(pb)) REPS(pb) {
                pg8::Gemm g{XB, (const bf16*)(ws + WS_WA_IN) + (size_t)j * NA_IN * D_MODEL, M_TOK, NA_IN, D_MODEL}; pg8::StaticOrder S; S.init(M_TOK, NA_IN, G, (int)blockIdx.x);
                pg8::EpiA1 E{ssp, UZ, V, ssvp, args.in[4] + (size_t)j * D_INNER, (LAS float*)(lds + RS_OFF)};
                pg8::gemm_phase<pg8::EpiA1, pg8::StaticOrder, true, true>(lds, g, S, E);
            }
            SEAM(pb);
            if (IN(pb + 1)) REPS(pb + 1) { RELOAD_TID(); mixA_phase(args, j, lds, tid, wave, lane, DRY); }
            SEAM(pb + 1);
        } else {
            if (IN(pb)) REPS(pb) {
                pg8::Gemm g{XB, (const bf16*)(ws + WS_WB_IN) + (size_t)j * NB_IN * D_MODEL, M_TOK, NB_IN, D_MODEL}; pg8::StaticOrder S; S.init(M_TOK, NB_IN, G, (int)blockIdx.x);
                pg8::EpiB1 E{ssp, UZ, args.in[9] + (size_t)j * 3 * D_INNER, (float*)(ws + WS_PL), (float*)(ws + WS_P0), (float*)(ws + WS_Q0), (LAS float*)(lds + EXCH_OFF), (LAS float*)(lds + RS_OFF), DRY ? PROBE_DRYMODE : 0};
                pg8::gemm_phase<pg8::EpiB1, pg8::StaticOrder, true, true>(lds, g, S, E);
            }
            SEAM(pb);
        }
        if (IN(pb + 2)) REPS(pb + 2) {
            const bool isB = (l & 1) != 0;
            pg8::Gemm g{UZ, (const bf16*)(ws + (isB ? WS_WB_OUT : WS_WA_OUT)) + (size_t)j * D_MODEL * D_INNER, M_TOK, D_MODEL, D_INNER}; pg8::StaticOrder S; S.init(M_TOK, D_MODEL, G, (int)blockIdx.x);
            if (isB) { RELOAD_TID();
                { pg8::Unit fu; int lastpm = -1; for (int i = 0; S.next(i, fu); ++i) if (fu.pm != lastpm) { convB_fixup(args, j, fu.pm, tid); lastpm = fu.pm; } }
                asm volatile("s_waitcnt vmcnt(0)" ::: "memory"); __syncthreads(); }
            pg8::EpiOut E{XB, ssp, DRY ? (PROBE_DRYMODE ? PROBE_DRYMODE : 1) : 0};
            pg8::gemm_phase<pg8::EpiOut, pg8::StaticOrder, false, true>(lds, g, S, E);
        }
        SEAM(pb + 2);
    }
    if (IN(13)) REPS(13) { RELOAD_TID(); final_phase(args, wave, lane, DRY); }
#undef IN
#undef SEAM
}

extern "C" void kernel_launch(void* const* d_in, const int* in_sizes, int n_in, void* d_out, int out_size, void* d_ws, size_t ws_size, hipStream_t stream) {
    static int grid = 0;
    if (grid == 0) {
        if (n_in != 11 || in_sizes[0] != M_TOK * D_MODEL || out_size != M_TOK * D_MODEL || ws_size < WS_END) { fprintf(stderr, "kernel_launch: unexpected shapes (n_in %d, in0 %d, out %d, ws %zu); nothing launched\n", n_in, n_in > 0 ? in_sizes[0] : -1, out_size, ws_size); grid = -1; return; }
        int dev = 0, cus = 0, per_cu = 0;
        if (hipGetDevice(&dev) != hipSuccess || hipDeviceGetAttribute(&cus, hipDeviceAttributeMultiprocessorCount, dev) != hipSuccess) { fprintf(stderr, "kernel_launch: device query failed\n"); grid = -1; return; }
        if (hipFuncSetAttribute((const void*)trunk_fwd, hipFuncAttributeMaxDynamicSharedMemorySize, LDS_BYTES) != hipSuccess) { fprintf(stderr, "kernel_launch: hipFuncSetAttribute failed\n"); grid = -1; return; }
        if (hipOccupancyMaxActiveBlocksPerMultiprocessor(&per_cu, (const void*)trunk_fwd, NWAVES * 64, LDS_BYTES) != hipSuccess || per_cu < 1) { fprintf(stderr, "kernel_launch: occupancy query says %d blocks per CU\n", per_cu); per_cu = 1; }
        (void)hipGetLastError();
        grid = cus * per_cu;
        fprintf(stderr, "kernel_launch: grid %d (cus %d x %d)\n", grid, cus, per_cu);
    }
    if (grid < 0) return;
    if (hipMemsetAsync((char*)d_ws + WS_CTL, 0, CTL_ZERO_BYTES, stream) != hipSuccess) { fprintf(stderr, "kernel_launch: hipMemsetAsync failed\n"); return; }
    Args a{};
    for (int i = 0; i < 11; ++i) a.in[i] = (const float*)d_in[i];
    a.out = (float*)d_out; a.ws = (unsigned char*)d_ws;
#if MK_ONE_LAUNCH
    a.ph_lo = 0; a.ph_hi = N_PHASES;
    void* kargs[] = {&a};
    hipError_t e = hipLaunchCooperativeKernel((const void*)trunk_fwd, dim3(grid), dim3(NWAVES * 64), kargs, LDS_BYTES, stream);
    if (e != hipSuccess) fprintf(stderr, "kernel_launch: cooperative launch failed: %s (grid %d)\n", hipGetErrorString(e), grid);
#else
    for (int p = 0; p < N_PHASES; ++p) { a.ph_lo = p; a.ph_hi = p + 1;
        hipLaunchKernelGGL(trunk_fwd, dim3(grid), dim3(NWAVES * 64), LDS_BYTES, stream, a);
        const hipError_t le = hipPeekAtLastError(); if (le != hipSuccess) { fprintf(stderr, "kernel_launch: launch %d failed: %s\n", p, hipGetErrorName(le)); break; } }
#endif
}
```
